# Optimizing an MI355X kernel written in HIP

```python
import jax, jax.numpy as jnp
from jax import lax
import numpy as np

D_MODEL = 1024
BATCH = 4
SEQ = 4096
DEPTH = 1

CHUNK = 64
HEAD_DIM = 64
N_HEADS_A = 8
N_HEADS_B = 8
WIDTH_A = N_HEADS_A * HEAD_DIM
WIDTH_B = N_HEADS_B * HEAD_DIM
Q_BLOCK = 128
LEFT_CHUNKS = 8
BAND_CHUNKS = LEFT_CHUNKS + 1
BAND = BAND_CHUNKS * CHUNK
REL_CLIP = 128
N_REL = 2 * REL_CLIP + 1
D_FF = 2816
EPS = 1e-6
N_MOD = 9
FORGET_BIAS_CENTER = 3.0
NEG_INF = -1e30
IN_SIZES = (WIDTH_A, WIDTH_A, WIDTH_A, N_HEADS_A, WIDTH_B, WIDTH_B, WIDTH_B, D_MODEL, D_MODEL)
IN_COLS = sum(IN_SIZES)

kernel_name = "hybrid_fox_chunkrel_macaron_block"


def rms_norm(x, g):
    xf = x.astype(jnp.float32)
    y = xf * lax.rsqrt(jnp.mean(xf * xf, axis=-1, keepdims=True) + EPS)
    return (y * g.astype(jnp.float32)).astype(x.dtype)


def modulate(h, shift, scale):
    return h * (1.0 + scale[:, None, :]) + shift[:, None, :]


def swiglu(h, w_gate, w_up, w_down):
    return (jax.nn.silu(h @ w_gate) * (h @ w_up)) @ w_down


def forgetting_attention(q, k, v, log_f):
    B, S, H, dh = q.shape
    nb = S // Q_BLOCK
    F = jnp.cumsum(log_f, axis=1)
    F_k = F.transpose(0, 2, 1)
    q_blocks = q.reshape(B, nb, Q_BLOCK, H, dh).transpose(1, 0, 2, 3, 4)
    F_blocks = F.reshape(B, nb, Q_BLOCK, H).transpose(1, 0, 3, 2)
    starts = jnp.arange(nb, dtype=jnp.int32) * Q_BLOCK
    k_pos = jnp.arange(S, dtype=jnp.int32)
    scale = HEAD_DIM ** -0.5

    def one_block(args):
        qb, Fq, start = args
        s = jnp.einsum('bqhd,bkhd->bhqk', qb, k).astype(jnp.float32) * scale
        s = s + Fq[..., None] - F_k[:, :, None, :]
        q_pos = start + jnp.arange(Q_BLOCK, dtype=jnp.int32)
        mask = k_pos[None, :] <= q_pos[:, None]
        s = jnp.where(mask[None, None], s, NEG_INF)
        p = jax.nn.softmax(s, axis=-1).astype(v.dtype)
        return jnp.einsum('bhqk,bkhd->bqhd', p, v)

    out = lax.map(one_block, (q_blocks, F_blocks, starts))
    return out.transpose(1, 0, 2, 3, 4).reshape(B, S, H * dh)


def chunked_relpos_attention(q, k, v, rel_bias):
    B, S, H, dh = q.shape
    nc = S // CHUNK
    qc = q.reshape(B, nc, CHUNK, H, dh)
    pad = ((0, 0), (LEFT_CHUNKS, 0), (0, 0), (0, 0), (0, 0))
    kp = jnp.pad(k.reshape(B, nc, CHUNK, H, dh), pad)
    vp = jnp.pad(v.reshape(B, nc, CHUNK, H, dh), pad)
    k_band = jnp.concatenate([kp[:, j:j + nc] for j in range(BAND_CHUNKS)], axis=2)
    v_band = jnp.concatenate([vp[:, j:j + nc] for j in range(BAND_CHUNKS)], axis=2)
    s = jnp.einsum('bnqhd,bnkhd->bnhqk', qc, k_band).astype(jnp.float32) * (HEAD_DIM ** -0.5)
    qi = jnp.arange(CHUNK, dtype=jnp.int32)
    kj = jnp.arange(BAND, dtype=jnp.int32)
    dist = LEFT_CHUNKS * CHUNK + qi[:, None] - kj[None, :]
    idx = jnp.clip(dist, -REL_CLIP, REL_CLIP) + REL_CLIP
    bias = rel_bias.astype(jnp.float32)[:, idx]
    s = s + bias[None, None]
    chunk_ids = jnp.arange(nc, dtype=jnp.int32)[:, None] - LEFT_CHUNKS + jnp.arange(BAND_CHUNKS, dtype=jnp.int32)[None, :]
    key_valid = jnp.repeat(chunk_ids >= 0, CHUNK, axis=1)
    s = jnp.where(key_valid[None, :, None, None, :], s, NEG_INF)
    p = jax.nn.softmax(s, axis=-1).astype(v.dtype)
    out = jnp.einsum('bnhqk,bnkhd->bnqhd', p, v_band)
    return out.reshape(B, S, H * dh)


def token_mixing(h, w_in, forget_b, branch_gate_b, rel_bias, branch_w_a, branch_w_b, w_out):
    B, S, _ = h.shape
    proj = h @ w_in
    offs = np.cumsum((0,) + IN_SIZES)
    qa, ka, va, fa, qb, kb, vb, ga, gb = [proj[..., int(offs[i]):int(offs[i + 1])] for i in range(len(IN_SIZES))]
    heads = lambda t, n: t.reshape(B, S, n, HEAD_DIM)
    log_f = jax.nn.log_sigmoid(fa.astype(jnp.float32) + forget_b.astype(jnp.float32))
    y_a = forgetting_attention(heads(qa, N_HEADS_A), heads(ka, N_HEADS_A), heads(va, N_HEADS_A), log_f) @ branch_w_a
    y_b = chunked_relpos_attention(heads(qb, N_HEADS_B), heads(kb, N_HEADS_B), heads(vb, N_HEADS_B), rel_bias) @ branch_w_b
    g_a = jax.nn.sigmoid(ga + branch_gate_b[:D_MODEL])
    g_b = jax.nn.sigmoid(gb + branch_gate_b[D_MODEL:])
    return (g_a * y_a + g_b * y_b) @ w_out


def setup_inputs(seed: int = 0) -> dict:
    key = jax.random.key(seed)
    ks = jax.random.split(key, 24)
    nrm = lambda k, shape, s: jax.random.normal(k, shape, jnp.float32) * s
    L, D = DEPTH, D_MODEL
    return {
        "x": nrm(ks[0], (BATCH, SEQ, D), 1.0),
        "c": nrm(ks[1], (BATCH, D), 1.0),
        "ada_w": nrm(ks[2], (L, D, N_MOD * D), 0.5 * D ** -0.5),
        "ada_b": nrm(ks[3], (L, N_MOD * D), 0.02),
        "norm_ffn1": 1.0 + nrm(ks[4], (L, D), 0.05),
        "ffn1_w_gate": nrm(ks[5], (L, D, D_FF), D ** -0.5),
        "ffn1_w_up": nrm(ks[6], (L, D, D_FF), D ** -0.5),
        "ffn1_w_down": nrm(ks[7], (L, D_FF, D), D_FF ** -0.5),
        "norm_mix": 1.0 + nrm(ks[8], (L, D), 0.05),
        "mix_w_in": nrm(ks[9], (L, D, IN_COLS), D ** -0.5),
        "forget_b": FORGET_BIAS_CENTER + nrm(ks[10], (L, N_HEADS_A), 0.1),
        "branch_gate_b": nrm(ks[11], (L, 2 * D), 0.02),
        "rel_bias": nrm(ks[12], (L, N_HEADS_B, N_REL), 0.5),
        "branch_w_a": nrm(ks[13], (L, WIDTH_A, D), WIDTH_A ** -0.5),
        "branch_w_b": nrm(ks[14], (L, WIDTH_B, D), WIDTH_B ** -0.5),
        "mix_w_out": nrm(ks[15], (L, D, D), D ** -0.5),
        "norm_ffn2": 1.0 + nrm(ks[16], (L, D), 0.05),
        "ffn2_w_gate": nrm(ks[17], (L, D, D_FF), D ** -0.5),
        "ffn2_w_up": nrm(ks[18], (L, D, D_FF), D ** -0.5),
        "ffn2_w_down": nrm(ks[19], (L, D_FF, D), D_FF ** -0.5),
        "final_norm": 1.0 + nrm(ks[20], (D,), 0.05),
    }


def reference(x, c, ada_w, ada_b, norm_ffn1, ffn1_w_gate, ffn1_w_up, ffn1_w_down,
              norm_mix, mix_w_in, forget_b, branch_gate_b, rel_bias, branch_w_a, branch_w_b,
              mix_w_out, norm_ffn2, ffn2_w_gate, ffn2_w_up, ffn2_w_down, final_norm):
    c_act = jax.nn.silu(c)
    for l in range(DEPTH):
        mod = c_act @ ada_w[l] + ada_b[l]
        sh1, sc1, g1, sh2, sc2, g2, sh3, sc3, g3 = jnp.split(mod, N_MOD, axis=-1)
        h = modulate(rms_norm(x, norm_ffn1[l]), sh1, sc1)
        x = x + 0.5 * g1[:, None, :] * swiglu(h, ffn1_w_gate[l], ffn1_w_up[l], ffn1_w_down[l])
        h = modulate(rms_norm(x, norm_mix[l]), sh2, sc2)
        x = x + g2[:, None, :] * token_mixing(h, mix_w_in[l], forget_b[l], branch_gate_b[l], rel_bias[l],
                                              branch_w_a[l], branch_w_b[l], mix_w_out[l])
        h = modulate(rms_norm(x, norm_ffn2[l]), sh3, sc3)
        x = x + 0.5 * g3[:, None, :] * swiglu(h, ffn2_w_gate[l], ffn2_w_up[l], ffn2_w_down[l])
    return rms_norm(x, final_norm)
```

```cpp
#include <hip/hip_runtime.h>
#include <hip/hip_cooperative_groups.h>
#include <cstdio>
#include <cstdint>
namespace pg8 {
#define PG8_LAS __attribute__((address_space(3)))
typedef unsigned short bf16_t;
typedef short bf16x8 __attribute__((ext_vector_type(8)));
typedef float f32x4 __attribute__((ext_vector_type(4)));
typedef unsigned u32x4 __attribute__((ext_vector_type(4)));
constexpr int BM = 256, BK = 64, HALF = 128, HTB = HALF * BK * 2  , STAGE_BYTES = 8 * HTB, NXCD = 8, WGM = 2;

__host__ __device__ __forceinline__ int lds_byte(int r, int c) { const int st = (r >> 4) * 2 + (c >> 5), rr = r & 15, cc = c & 31, ob = rr * 64 + cc * 2; return st * 1024 + (ob ^ (((ob >> 9) & 1) << 5)); }
__host__ __device__ __forceinline__ void stage_rc(int b, int& R, int& C) { const int st = b / 1024, sb = b % 1024, swz = sb ^ (((sb >> 9) & 1) << 5); R = (st >> 1) * 16 + swz / 64; C = (st & 1) * 32 + (swz % 64) / 2; }
__host__ __device__ __forceinline__ int perm32(int rho) { const int n = rho >> 4, i = rho & 15; return 8 * (i >> 2) + 4 * n + (i & 3); }

struct Unit { int pm, pn; };
struct Gemm { const bf16_t* A; const bf16_t* Bt; int M, N, K; };

template <int REPS = 1> struct StaticOrderT {
    int nM, nN, nwg, G, c;
    __host__ __device__ void init(int M, int N, int G_, int c_) { nM = M / BM; nN = N / BM; nwg = nM * nN; G = G_; c = c_; }
    __host__ __device__ bool next(int i, Unit& u) const {
        const long L = (long)i * G + c; if (L >= (long)nwg * REPS) return false;
        int wgid = (REPS > 1) ? (int)(L % nwg) : (int)L; { const int q = nwg / NXCD, r = nwg % NXCD, xcd = wgid % NXCD, off = wgid / NXCD; wgid = (xcd < r ? xcd * (q + 1) : r * (q + 1) + (xcd - r) * q) + off; }
        const int nig = WGM * nN, gid = wgid / nig, fm = gid * WGM, gsz = (nM - fm) < WGM ? (nM - fm) : WGM;
        u.pm = fm + ((wgid % nig) % gsz); u.pn = (wgid % nig) / gsz; return true;
    }
    __device__ __forceinline__ void a_ready(const Unit&) const {}
    __device__ __forceinline__ void done(const Unit&) const {}
};
typedef StaticOrderT<1> StaticOrder;

__device__ __forceinline__ unsigned cvt_pk_bf16(float lo, float hi) { unsigned r; asm volatile("v_cvt_pk_bf16_f32 %0, %1, %2" : "=v"(r) : "v"(lo), "v"(hi)); return r; }
template <class Epi, class Sched, bool ALIGN_EPI = false, bool SP2 = false, int MIDT = 0>
__device__ __forceinline__ void gemm_phase(PG8_LAS unsigned char* lds, const Gemm g, const Sched& S, const Epi& E) {
    int tid_ = threadIdx.x; asm volatile("" : "+v"(tid_));
    const int tid = tid_, wid = __builtin_amdgcn_readfirstlane(tid >> 6), lane = tid & 63, wr = wid >> 2, wc = wid & 3, fr = lane & 15, fq = lane >> 4;
    const int K = g.K, nt = K / BK;
    unsigned voffA[2], voffB[2];
#pragma unroll
    for (int i = 0; i < 2; ++i) { int R, C; stage_rc(tid * 16 + i * 8192, R, C); const int Rb = Epi::PERM ? ((R & ~31) + perm32(R & 31)) : R;
        voffA[i] = (unsigned)(R * K + C) * 2u; voffB[i] = (unsigned)(Rb * K + C) * 2u; }
    const size_t kstep = (size_t)(BK * 2);
    const size_t hstep = (size_t)HALF * K * 2;
    const size_t tstep = 2 * hstep;
    const unsigned ldsw = (unsigned)wid * 1024u;
    const int aoff = lds_byte(wr * 64 + fr, fq * 8), boff = lds_byte(wc * 32 + fr, fq * 8);
#define PG8_SA(b, h) (((b) * 2 + (h)) * HTB)
#define PG8_SB(b, h) ((4 + (b) * 2 + (h)) * HTB)
#define PG8_STAGE(bufoff, gbase, voff) do { _Pragma("unroll") for (int _i = 0; _i < 2; ++_i) \
        __builtin_amdgcn_global_load_lds((const unsigned*)((const char*)(gbase) + (voff)[_i]), (PG8_LAS unsigned*)(lds + (bufoff) + ldsw + _i * 8192), 16, 0, 0); } while (0)
#define PG8_LDA(dst, b, h) do { _Pragma("unroll") for (int m = 0; m < 4; ++m) _Pragma("unroll") for (int k = 0; k < 2; ++k) dst[m][k] = *(const PG8_LAS bf16x8*)(lds + PG8_SA(b, h) + aoff + m * 2048 + k * 1024); } while (0)
#define PG8_LDB(dst, b, h) do { _Pragma("unroll") for (int n = 0; n < 2; ++n) _Pragma("unroll") for (int k = 0; k < 2; ++k) dst[n][k] = *(const PG8_LAS bf16x8*)(lds + PG8_SB(b, h) + boff + n * 2048 + k * 1024); } while (0)
#define PG8_MMA(ai, bj, At, Bt) do { __builtin_amdgcn_s_setprio(1); _Pragma("unroll") for (int m = 0; m < 4; ++m) _Pragma("unroll") for (int n = 0; n < 2; ++n) _Pragma("unroll") for (int k = 0; k < 2; ++k) \
        acc[ai][bj][m][n] = __builtin_amdgcn_mfma_f32_16x16x32_bf16(Bt[n][k], At[m][k], acc[ai][bj][m][n], 0, 0, 0); __builtin_amdgcn_s_setprio(0); } while (0)
#define PG8_WAIT_V(n) asm volatile("s_waitcnt vmcnt(" #n ")" ::: "memory")
#define PG8_WAIT_L(n) asm volatile("s_waitcnt lgkmcnt(" #n ")" ::: "memory")
#define PG8_BAR __builtin_amdgcn_s_barrier()
#define PG8_SCHED __builtin_amdgcn_sched_barrier(0)
    Unit cur, nxt; int ui = 0;
    if (!S.next(0, cur)) return;
    f32x4 acc[2][2][4][2];
#pragma unroll
    for (int a = 0; a < 2; ++a)
#pragma unroll
        for (int b = 0; b < 2; ++b)
#pragma unroll
            for (int m = 0; m < 4; ++m)
#pragma unroll
                for (int n = 0; n < 2; ++n) acc[a][b][m][n] = (f32x4){0.f, 0.f, 0.f, 0.f};
    bf16x8 At[4][2], B0[2][2], B1[2][2];
    const char* cA = (const char*)g.A + (size_t)cur.pm * tstep; const char* cB = (const char*)g.Bt + (size_t)cur.pn * tstep;
    S.a_ready(cur);
    if constexpr (SP2) {
        PG8_STAGE(PG8_SB(0, 0), cB, voffB); PG8_STAGE(PG8_SB(0, 1), cB + hstep, voffB); PG8_STAGE(PG8_SA(0, 0), cA, voffA); PG8_STAGE(PG8_SA(0, 1), cA + hstep, voffA);
        if (wr == 1) PG8_BAR;
        PG8_WAIT_V(2); PG8_BAR;
        PG8_STAGE(PG8_SB(1, 0), cB + kstep, voffB); PG8_STAGE(PG8_SA(1, 0), cA + kstep, voffA); PG8_STAGE(PG8_SB(1, 1), cB + hstep + kstep, voffB);
        PG8_WAIT_V(6); PG8_BAR;
    } else {
        PG8_STAGE(PG8_SB(0, 0), cB, voffB); PG8_STAGE(PG8_SA(0, 0), cA, voffA); PG8_STAGE(PG8_SB(0, 1), cB + hstep, voffB); PG8_STAGE(PG8_SA(0, 1), cA + hstep, voffA);
        if (wr == 1) PG8_BAR;
        PG8_WAIT_V(4); PG8_BAR;
        PG8_STAGE(PG8_SB(1, 0), cB + kstep, voffB); PG8_STAGE(PG8_SA(1, 0), cA + kstep, voffA); PG8_STAGE(PG8_SB(1, 1), cB + hstep + kstep, voffB);
        PG8_WAIT_V(6); PG8_BAR;
    }
    for (;;) {
        const bool has_next = S.next(ui + 1, nxt);
        const char* nA = has_next ? (const char*)g.A + (size_t)nxt.pm * tstep : cA; const char* nB = has_next ? (const char*)g.Bt + (size_t)nxt.pn * tstep : cB;
        for (int t = 0; t < nt; t += 2) {
            const bool last = (t == nt - 2);
            if constexpr (MIDT > 0) { if (t == MIDT) E.mid(acc, cur, wr, wc, fr, fq); }
            const char* a1 = cA + (size_t)(t + 1) * kstep;
            const char* a2 = last ? nA : cA + (size_t)(t + 2) * kstep; const char* b2 = last ? nB : cB + (size_t)(t + 2) * kstep;
            const char* a3 = a2 + kstep; const char* b3 = b2 + kstep;
            if (last && has_next) S.a_ready(nxt);
            if constexpr (SP2) {
            PG8_LDB(B0, 0, 0); PG8_LDB(B1, 0, 1); PG8_SCHED; PG8_LDA(At, 0, 0); PG8_STAGE(PG8_SA(1, 1), a1 + hstep, voffA);
            PG8_WAIT_V(8); PG8_WAIT_L(0); PG8_BAR; PG8_MMA(0, 0, At, B0); PG8_MMA(0, 1, At, B1); PG8_BAR; PG8_SCHED;
            PG8_LDA(At, 0, 1); PG8_STAGE(PG8_SB(0, 0), b2, voffB); PG8_STAGE(PG8_SB(0, 1), b2 + hstep, voffB); PG8_STAGE(PG8_SA(0, 0), a2, voffA);
            PG8_WAIT_V(8); PG8_WAIT_L(0); PG8_BAR; PG8_MMA(1, 0, At, B0); PG8_MMA(1, 1, At, B1); PG8_BAR; PG8_SCHED;
            PG8_LDB(B0, 1, 0); PG8_LDB(B1, 1, 1); PG8_SCHED; PG8_LDA(At, 1, 0); PG8_STAGE(PG8_SA(0, 1), a2 + hstep, voffA);
            PG8_WAIT_V(8); PG8_WAIT_L(0); PG8_BAR; PG8_MMA(0, 0, At, B0); PG8_MMA(0, 1, At, B1); PG8_BAR; PG8_SCHED;
            PG8_LDA(At, 1, 1); PG8_STAGE(PG8_SB(1, 0), b3, voffB); PG8_STAGE(PG8_SB(1, 1), b3 + hstep, voffB); PG8_STAGE(PG8_SA(1, 0), a3, voffA);
            PG8_WAIT_V(8); PG8_WAIT_L(0); PG8_BAR; PG8_MMA(1, 0, At, B0); PG8_MMA(1, 1, At, B1); PG8_BAR; PG8_SCHED;
            } else {
            PG8_LDB(B0, 0, 0); PG8_SCHED; PG8_LDA(At, 0, 0); PG8_STAGE(PG8_SA(1, 1), a1 + hstep, voffA);
            PG8_WAIT_L(8); PG8_BAR; PG8_WAIT_L(0); PG8_MMA(0, 0, At, B0); PG8_BAR; PG8_SCHED;
            PG8_LDB(B1, 0, 1); PG8_STAGE(PG8_SB(0, 0), b2, voffB);
            PG8_BAR; PG8_WAIT_L(0); PG8_MMA(0, 1, At, B1); PG8_BAR;
            PG8_LDA(At, 0, 1); PG8_STAGE(PG8_SA(0, 0), a2, voffA);
            PG8_BAR; PG8_WAIT_L(0); PG8_MMA(1, 0, At, B0); PG8_BAR; PG8_SCHED;
            PG8_STAGE(PG8_SB(0, 1), b2 + hstep, voffB);
            PG8_WAIT_V(6); PG8_BAR; PG8_MMA(1, 1, At, B1); PG8_BAR;
            PG8_LDB(B0, 1, 0); PG8_SCHED; PG8_LDA(At, 1, 0); PG8_STAGE(PG8_SA(0, 1), a2 + hstep, voffA);
            PG8_WAIT_L(8); PG8_BAR; PG8_WAIT_L(0); PG8_MMA(0, 0, At, B0); PG8_BAR; PG8_SCHED;
            PG8_LDB(B1, 1, 1); PG8_STAGE(PG8_SB(1, 0), b3, voffB);
            PG8_BAR; PG8_WAIT_L(0); PG8_MMA(0, 1, At, B1); PG8_BAR;
            PG8_LDA(At, 1, 1); PG8_STAGE(PG8_SA(1, 0), a3, voffA);
            PG8_BAR; PG8_WAIT_L(0); PG8_MMA(1, 0, At, B0); PG8_BAR; PG8_SCHED;
            PG8_STAGE(PG8_SB(1, 1), b3 + hstep, voffB);
            PG8_WAIT_V(6); PG8_BAR; PG8_MMA(1, 1, At, B1); PG8_BAR;
            }
        }
        if constexpr (ALIGN_EPI) { if (wr == 0) PG8_BAR; }
        if constexpr (!Epi::AFTER_DRAIN) { E(acc, cur, wr, wc, fr, fq); S.done(cur); }
        if (!has_next) break;
#pragma unroll
        for (int a = 0; a < 2; ++a)
#pragma unroll
            for (int b = 0; b < 2; ++b)
#pragma unroll
                for (int m = 0; m < 4; ++m)
#pragma unroll
                    for (int n = 0; n < 2; ++n) acc[a][b][m][n] = (f32x4){0.f, 0.f, 0.f, 0.f};
        cur = nxt; cA = nA; cB = nB; ++ui;
        if constexpr (ALIGN_EPI) { if (wr == 1) PG8_BAR; }
    }
    PG8_WAIT_V(0);
    if constexpr (!ALIGN_EPI) { if (wr == 0) PG8_BAR; }
    PG8_BAR;
    if constexpr (Epi::AFTER_DRAIN) { E.fused(acc, cur, wr, wc, fr, fq, lds, wid, lane); S.done(cur); }
#undef PG8_SA
#undef PG8_SB
#undef PG8_STAGE
#undef PG8_LDA
#undef PG8_LDB
#undef PG8_MMA
#undef PG8_WAIT_V
#undef PG8_WAIT_L
#undef PG8_BAR
#undef PG8_SCHED
}
}
namespace cg = cooperative_groups;
#define LAS __attribute__((address_space(3)))
using pg8::bf16_t; using pg8::bf16x8; using pg8::f32x4; using pg8::u32x4; using pg8::cvt_pk_bf16;
typedef float f32x16 __attribute__((ext_vector_type(16)));
typedef unsigned u32x2 __attribute__((ext_vector_type(2)));
typedef _Float16 h16x8 __attribute__((ext_vector_type(8)));

constexpr int T_TOK = 16384, DM = 1024, SEQ = 4096, DFF = 2816, NMOD = 9216, INC = 5128;
constexpr float LOG2E = 1.4426950408889634f, C2 = 0.125f * 1.4426950408889634f, EPS = 1e-6f;
constexpr size_t MiB = 1u << 20;
constexpr size_t WS_GS2 = 160 * 1024, WS_GS3 = 176 * 1024, WS_WF = 192 * 1024;
constexpr size_t WS_MOD = 0, WS_LOGF = 256 * 1024, WS_F2 = 768 * 1024, WS_BAR = 1536 * 1024, BAR_BYTES = 32768, WS_CNT = WS_BAR + 16384, WS_XCH = 768 * 1024;
constexpr size_t SZ_WGU = (size_t)5632 * 1024 * 2, SZ_WD = (size_t)1024 * 2816 * 2;
constexpr size_t WS_WGU1 = 2 * MiB, WS_WD1 = WS_WGU1 + SZ_WGU, WS_WGU2 = WS_WD1 + SZ_WD, WS_WD2 = WS_WGU2 + SZ_WGU, WS_WIN = WS_WD2 + SZ_WD;
constexpr size_t WS_WAB = WS_WIN + 10 * MiB, WS_WOUT = WS_WAB + 2 * MiB, WS_H = WS_WOUT + 2 * MiB;
static_assert(WS_H == 49 * MiB, "ws map");
constexpr size_t WS_ACT = 81 * MiB;
constexpr size_t WS_QA = 81 * MiB, WS_KA = 97 * MiB, WS_VTA = 113 * MiB, WS_QB = 129 * MiB, WS_KB = 145 * MiB, WS_VTB = 161 * MiB, WS_RATIO = 177 * MiB, WS_GB = 209 * MiB, WS_END = 241 * MiB;
constexpr size_t WS_ATT = WS_H, WS_M = WS_QA, WS_TMP = WS_VTA;
constexpr int LDS_BYTES = 131072 + 1024;
#ifndef PHMASK
#define PHMASK 0xFFFF
#endif
#ifndef ATT_REPS
#define ATT_REPS 1
#endif
#ifndef R_P2
#define R_P2 1
#endif
#ifndef R_P3
#define R_P3 1
#endif
#ifndef R_P5
#define R_P5 1
#endif
#ifndef R_P7
#define R_P7 1
#endif
#ifndef R_P0
#define R_P0 1
#endif
#ifndef R_P1
#define R_P1 1
#endif

#define LAUNDER_TID() int tid = threadIdx.x; asm volatile("" : "+v"(tid)); const int lane = tid & 63, wave = __builtin_amdgcn_readfirstlane(tid >> 6); (void)lane; (void)wave
__device__ __forceinline__ float wave_sum(float v) {
#pragma unroll
    for (int o = 1; o < 64; o <<= 1) v += __shfl_xor(v, o);
    return v;
}
__device__ __forceinline__ float silu_f(float x) { return x * __builtin_amdgcn_rcpf(1.0f + __builtin_amdgcn_exp2f(-x * LOG2E)); }

template <class Q> struct Epi {
    static constexpr bool PERM = true, AFTER_DRAIN = false; Q q;
    __device__ __forceinline__ void operator()(f32x4 (&acc)[2][2][4][2], const pg8::Unit& u, int wr, int wc, int fr, int fq) const {
        const int row0 = u.pm * 256 + wr * 64 + fr, c0 = wc * 32 + 8 * fq;
#pragma unroll
        for (int ai = 0; ai < 2; ++ai)
#pragma unroll
            for (int m = 0; m < 4; ++m) q.oct(row0 + ai * 128 + m * 16, u.pn, c0, acc[ai][0][m][0], acc[ai][0][m][1], acc[ai][1][m][0], acc[ai][1][m][1]);
    }
    __device__ __forceinline__ void mid(f32x4 (&acc)[2][2][4][2], const pg8::Unit& u, int wr, int wc, int fr, int fq) const {
        const int row0 = u.pm * 256 + wr * 64 + fr, c0 = wc * 32 + 8 * fq;
#pragma unroll
        for (int ai = 0; ai < 2; ++ai)
#pragma unroll
            for (int m = 0; m < 4; ++m) { q.mid(row0 + ai * 128 + m * 16, u.pn, c0, acc[ai][0][m][0], acc[ai][0][m][1], acc[ai][1][m][0], acc[ai][1][m][1]); asm volatile("" ::: "memory"); }
    }
};
__device__ __forceinline__ u32x4 pack8(f32x4 lo, f32x4 hi) { u32x4 w; w.x = cvt_pk_bf16(lo[0], lo[1]); w.y = cvt_pk_bf16(lo[2], lo[3]); w.z = cvt_pk_bf16(hi[0], hi[1]); w.w = cvt_pk_bf16(hi[2], hi[3]); return w; }

struct QSwiglu {
    bf16_t* O;
    __device__ __forceinline__ void oct(int row, int pn, int c0, f32x4 a0, f32x4 a1, f32x4 b0, f32x4 b1) const {
        f32x4 lo, hi;
#pragma unroll
        for (int i = 0; i < 4; ++i) { lo[i] = silu_f(a0[i]) * b0[i]; hi[i] = silu_f(a1[i]) * b1[i]; }
        *(u32x4*)(O + (size_t)row * DFF + pn * 128 + c0) = pack8(lo, hi);
    }
    __device__ __forceinline__ void mid(int, int, int, f32x4&, f32x4&, f32x4&, f32x4&) const {}
};
struct QResid {
    const float* base; float* out; const float* g; float coef;
    __device__ __forceinline__ void oct(int row, int pn, int c0, f32x4 a0, f32x4 a1, f32x4 b0, f32x4 b1) const {
        const int b = row >> 12; const float* gp = g + (size_t)b * NMOD + pn * 256 + c0; const size_t off = (size_t)row * DM + pn * 256 + c0;
        const f32x4 g0 = *(const f32x4*)gp, g1 = *(const f32x4*)(gp + 4), g2 = *(const f32x4*)(gp + 128), g3 = *(const f32x4*)(gp + 132);
        const f32x4 x0 = *(const f32x4*)(base + off), x1 = *(const f32x4*)(base + off + 4), x2 = *(const f32x4*)(base + off + 128), x3 = *(const f32x4*)(base + off + 132);
        *(f32x4*)(out + off) = x0 + coef * g0 * a0; *(f32x4*)(out + off + 4) = x1 + coef * g1 * a1;
        *(f32x4*)(out + off + 128) = x2 + coef * g2 * b0; *(f32x4*)(out + off + 132) = x3 + coef * g3 * b1;
    }
    __device__ __forceinline__ void mid(int, int, int, f32x4&, f32x4&, f32x4&, f32x4&) const {}
};
struct QWin {
    bf16_t *QA, *KA, *VTA, *QB, *KB, *VTB; _Float16 *RATIO, *GB; const float* bgate;
    __device__ __forceinline__ void oct(int row, int pn, int c0, f32x4 a0, f32x4 a1, f32x4 b0, f32x4 b1) const {
        if (pn < 12) {
            const int kind = pn >> 1, colb = 256 * (pn & 1) + c0;
            if (kind == 2 || kind == 5) {
                bf16_t* VT = (kind == 2) ? VTA : VTB; const int b = row >> 12, s = row & 4095;
#pragma unroll
                for (int i = 0; i < 8; ++i) {
                    const float va = i < 4 ? a0[i & 3] : a1[i & 3], vb = i < 4 ? b0[i & 3] : b1[i & 3];
                    const int ca = colb + i, cb = colb + 128 + i;
                    VT[((size_t)(b * 8 + (ca >> 6)) * 64 + (ca & 63)) * SEQ + s] = (bf16_t)(cvt_pk_bf16(va, 0.f) & 0xffffu);
                    VT[((size_t)(b * 8 + (cb >> 6)) * 64 + (cb & 63)) * SEQ + s] = (bf16_t)(cvt_pk_bf16(vb, 0.f) & 0xffffu);
                }
            } else {
                bf16_t* P = (kind == 0) ? QA : (kind == 1) ? KA : (kind == 3) ? QB : KB;
                const float sc = (kind == 0 || kind == 3) ? C2 : 1.0f;
                *(u32x4*)(P + (size_t)row * 512 + colb) = pack8(a0 * sc, a1 * sc);
                *(u32x4*)(P + (size_t)row * 512 + colb + 128) = pack8(b0 * sc, b1 * sc);
            }
        } else {
            const int col = 128 * (pn - 12) + c0;
            h16x8 r, gbv;
#pragma unroll
            for (int i = 0; i < 8; ++i) {
                const float za = (i < 4 ? a0[i & 3] : a1[i & 3]) + bgate[col + i], zb = (i < 4 ? b0[i & 3] : b1[i & 3]) + bgate[DM + col + i];
                const float ea = __builtin_amdgcn_exp2f(-za * LOG2E), eb = __builtin_amdgcn_exp2f(-zb * LOG2E);
                r[i] = (_Float16)((1.0f + eb) * __builtin_amdgcn_rcpf(1.0f + ea));
                gbv[i] = (_Float16)__builtin_amdgcn_rcpf(1.0f + eb);
            }
            *(h16x8*)(RATIO + (size_t)row * DM + col) = r; *(h16x8*)(GB + (size_t)row * DM + col) = gbv;
        }
    }
    __device__ __forceinline__ void mid(int, int, int, f32x4&, f32x4&, f32x4&, f32x4&) const {}
};
struct QGate1 {
    const _Float16* RATIO; float* TMP;
    __device__ __forceinline__ void oct(int row, int pn, int c0, f32x4 a0, f32x4 a1, f32x4 b0, f32x4 b1) const {
        const _Float16* rp = RATIO + (size_t)row * DM + pn * 256 + c0; const h16x8 r0 = *(const h16x8*)rp, r1 = *(const h16x8*)(rp + 128);
#pragma unroll
        for (int i = 0; i < 4; ++i) { a0[i] *= (float)r0[i]; a1[i] *= (float)r0[4 + i]; b0[i] *= (float)r1[i]; b1[i] *= (float)r1[4 + i]; }
        float* tp = TMP + (size_t)row * DM + pn * 256 + c0;
        *(f32x4*)tp = a0; *(f32x4*)(tp + 4) = a1; *(f32x4*)(tp + 128) = b0; *(f32x4*)(tp + 132) = b1;
    }
    __device__ __forceinline__ void mid(int, int, int, f32x4&, f32x4&, f32x4&, f32x4&) const {}
};
struct QGate2 {
    const _Float16* GB; const float* TMP; bf16_t* M;
    __device__ __forceinline__ void oct(int row, int pn, int c0, f32x4 a0, f32x4 a1, f32x4 b0, f32x4 b1) const {
        const _Float16* rp = GB + (size_t)row * DM + pn * 256 + c0; const h16x8 r0 = *(const h16x8*)rp, r1 = *(const h16x8*)(rp + 128);
        const float* tp = TMP + (size_t)row * DM + pn * 256 + c0;
        a0 += *(const f32x4*)tp; a1 += *(const f32x4*)(tp + 4); b0 += *(const f32x4*)(tp + 128); b1 += *(const f32x4*)(tp + 132);
#pragma unroll
        for (int i = 0; i < 4; ++i) { a0[i] *= (float)r0[i]; a1[i] *= (float)r0[4 + i]; b0[i] *= (float)r1[i]; b1[i] *= (float)r1[4 + i]; }
        bf16_t* mp = M + (size_t)row * DM + pn * 256 + c0;
        *(u32x4*)mp = pack8(a0, a1); *(u32x4*)(mp + 128) = pack8(b0, b1);
    }
    __device__ __forceinline__ void mid(int, int, int, f32x4&, f32x4&, f32x4&, f32x4&) const {}
};

struct QGate {
    const _Float16* RATIO; const _Float16* GB; bf16_t* M;
    __device__ __forceinline__ void mid(int row, int pn, int c0, f32x4& a0, f32x4& a1, f32x4& b0, f32x4& b1) const {
        const unsigned off = ((unsigned)row * DM + (unsigned)(pn * 256 + c0)) * 2u;
        const h16x8 r0 = *(const h16x8*)((const char*)RATIO + off), r1 = *(const h16x8*)((const char*)RATIO + off + 256);
#pragma unroll
        for (int i = 0; i < 4; ++i) { a0[i] *= (float)r0[i]; a1[i] *= (float)r0[4 + i]; b0[i] *= (float)r1[i]; b1[i] *= (float)r1[4 + i]; }
    }
    __device__ __forceinline__ void oct(int row, int pn, int c0, f32x4 a0, f32x4 a1, f32x4 b0, f32x4 b1) const {
        const _Float16* rp = GB + (size_t)row * DM + pn * 256 + c0; const h16x8 r0 = *(const h16x8*)rp, r1 = *(const h16x8*)(rp + 128);
#pragma unroll
        for (int i = 0; i < 4; ++i) { a0[i] *= (float)r0[i]; a1[i] *= (float)r0[4 + i]; b0[i] *= (float)r1[i]; b1[i] *= (float)r1[4 + i]; }
        bf16_t* mp = M + (size_t)row * DM + pn * 256 + c0;
        *(u32x4*)mp = pack8(a0, a1); *(u32x4*)(mp + 128) = pack8(b0, b1);
    }
};

template <int MODE> struct EpiResNorm {
    static constexpr bool PERM = true, AFTER_DRAIN = true;
    const float* base; float* xout; const float* g; float coef;
    bf16_t* H; const float* gs; const float* sh; const float* fin;
    float* xch; unsigned* cnt;
    __device__ __forceinline__ void fused(f32x4 (&acc)[2][2][4][2], const pg8::Unit& u, int wr, int wc, int fr, int fq, LAS unsigned char* lds, int wid, int lane) const {
        const int tid = wid * 64 + lane, c0 = wc * 32 + 8 * fq, b = (u.pm * 256) >> 12, colA = u.pn * 256 + c0, colB = colA + 128;
        LAS float* P = (LAS float*)lds; LAS float* S = (LAS float*)(lds + 4096);
        {
            const float* gp = g + (size_t)b * NMOD;
            const f32x4 g0 = *(const f32x4*)(gp + colA) * coef, g1 = *(const f32x4*)(gp + colA + 4) * coef, g2 = *(const f32x4*)(gp + colB) * coef, g3 = *(const f32x4*)(gp + colB + 4) * coef;
#pragma unroll
            for (int ai = 0; ai < 2; ++ai)
#pragma unroll
                for (int m = 0; m < 4; ++m) {
                    const int r = ai * 128 + wr * 64 + m * 16 + fr; const size_t off = (size_t)(u.pm * 256 + r) * DM;
                    const f32x4 x0 = *(const f32x4*)(base + off + colA) + g0 * acc[ai][0][m][0], x1 = *(const f32x4*)(base + off + colA + 4) + g1 * acc[ai][0][m][1];
                    const f32x4 x2 = *(const f32x4*)(base + off + colB) + g2 * acc[ai][1][m][0], x3 = *(const f32x4*)(base + off + colB + 4) + g3 * acc[ai][1][m][1];
                    acc[ai][0][m][0] = x0; acc[ai][0][m][1] = x1; acc[ai][1][m][0] = x2; acc[ai][1][m][1] = x3;
                    if (MODE == 0) { *(f32x4*)(xout + off + colA) = x0; *(f32x4*)(xout + off + colA + 4) = x1; *(f32x4*)(xout + off + colB) = x2; *(f32x4*)(xout + off + colB + 4) = x3; }
                    float ss = ((x0[0] * x0[0] + x0[1] * x0[1]) + (x0[2] * x0[2] + x0[3] * x0[3])) + ((x1[0] * x1[0] + x1[1] * x1[1]) + (x1[2] * x1[2] + x1[3] * x1[3]))
                             + ((x2[0] * x2[0] + x2[1] * x2[1]) + (x2[2] * x2[2] + x2[3] * x2[3])) + ((x3[0] * x3[0] + x3[1] * x3[1]) + (x3[2] * x3[2] + x3[3] * x3[3]));
                    ss += __shfl_xor(ss, 16); ss += __shfl_xor(ss, 32);
                    if (fq == 0) P[r * 4 + wc] = ss;
                    if (m & 1) asm volatile("" ::: "memory");
                }
        }
        __syncthreads();
        float* slot = xch + (size_t)(u.pm * 4) * 256;
        if (tid < 256) { const f32x4 p = *(const LAS f32x4*)(P + tid * 4); __hip_atomic_store(slot + u.pn * 256 + tid, (p[0] + p[1]) + (p[2] + p[3]), __ATOMIC_RELAXED, __HIP_MEMORY_SCOPE_AGENT);
            asm volatile("s_waitcnt vmcnt(0)" ::: "memory");
            if (lane == 0) __hip_atomic_fetch_add(cnt + 16 * u.pm, 1u, __ATOMIC_RELAXED, __HIP_MEMORY_SCOPE_AGENT); }
        if (wid == 0) {
            unsigned* c = cnt + 16 * u.pm; unsigned spins = 0;
            while ((unsigned)__builtin_amdgcn_readfirstlane(__hip_atomic_load(c, __ATOMIC_RELAXED, __HIP_MEMORY_SCOPE_AGENT)) < 16u) { __builtin_amdgcn_s_sleep(2); if (++spins > (1u << 22)) break; }
            __builtin_amdgcn_fence(__ATOMIC_ACQUIRE, "agent");
        }
        asm volatile("s_waitcnt vmcnt(0) lgkmcnt(0)" ::: "memory");
        __syncthreads();
        if (tid < 256) {
            const float t = (__hip_atomic_load(slot + tid, __ATOMIC_RELAXED, __HIP_MEMORY_SCOPE_AGENT) + __hip_atomic_load(slot + 256 + tid, __ATOMIC_RELAXED, __HIP_MEMORY_SCOPE_AGENT))
                          + (__hip_atomic_load(slot + 512 + tid, __ATOMIC_RELAXED, __HIP_MEMORY_SCOPE_AGENT) + __hip_atomic_load(slot + 768 + tid, __ATOMIC_RELAXED, __HIP_MEMORY_SCOPE_AGENT));
            S[tid] = 1.0f / sqrtf(t * (1.0f / DM) + EPS);
        }
        __syncthreads();
        {
            f32x4 m0, m1, m2, m3, s0, s1, s2, s3;
            if (MODE == 1) { m0 = *(const f32x4*)(fin + colA); m1 = *(const f32x4*)(fin + colA + 4); m2 = *(const f32x4*)(fin + colB); m3 = *(const f32x4*)(fin + colB + 4); }
            else { const float* gq = gs + (size_t)b * DM; const float* sq = sh + (size_t)b * NMOD;
                m0 = *(const f32x4*)(gq + colA); m1 = *(const f32x4*)(gq + colA + 4); m2 = *(const f32x4*)(gq + colB); m3 = *(const f32x4*)(gq + colB + 4);
                s0 = *(const f32x4*)(sq + colA); s1 = *(const f32x4*)(sq + colA + 4); s2 = *(const f32x4*)(sq + colB); s3 = *(const f32x4*)(sq + colB + 4); }
#pragma unroll
            for (int ai = 0; ai < 2; ++ai)
#pragma unroll
                for (int m = 0; m < 4; ++m) {
                    const int r = ai * 128 + wr * 64 + m * 16 + fr; const size_t off = (size_t)(u.pm * 256 + r) * DM; const float rstd = S[r];
                    if (MODE == 1) {
                        *(f32x4*)(xout + off + colA) = acc[ai][0][m][0] * rstd * m0; *(f32x4*)(xout + off + colA + 4) = acc[ai][0][m][1] * rstd * m1;
                        *(f32x4*)(xout + off + colB) = acc[ai][1][m][0] * rstd * m2; *(f32x4*)(xout + off + colB + 4) = acc[ai][1][m][1] * rstd * m3;
                    } else {
                        *(u32x4*)(H + off + colA) = pack8(acc[ai][0][m][0] * rstd * m0 + s0, acc[ai][0][m][1] * rstd * m1 + s1);
                        *(u32x4*)(H + off + colB) = pack8(acc[ai][1][m][0] * rstd * m2 + s2, acc[ai][1][m][1] * rstd * m3 + s3);
                    }
                }
        }
    }
};

__device__ __forceinline__ void transpose_item(const float* W, int ldw, int n0, int k0, bf16_t* WT, int ldk, int row0, int dk0, LAS float* scr, int lane) {
    {
        const int r8 = lane >> 3, c4 = 4 * (lane & 7); f32x4 v[8];
#pragma unroll
        for (int i = 0; i < 8; ++i) v[i] = *(const f32x4*)(W + (size_t)(k0 + 8 * i + r8) * ldw + n0 + c4);
#pragma unroll
        for (int i = 0; i < 8; ++i) { LAS float* d = scr + (8 * i + r8) * 33 + c4; d[0] = v[i][0]; d[1] = v[i][1]; d[2] = v[i][2]; d[3] = v[i][3]; }
    }
    asm volatile("s_waitcnt lgkmcnt(0)" ::: "memory");
    const int c = lane & 7;
#pragma unroll
    for (int j = 0; j < 4; ++j) { const int n = (lane >> 3) + 8 * j; const LAS float* s = scr + (8 * c) * 33 + n;
        u32x4 o; o.x = cvt_pk_bf16(s[0 * 33], s[1 * 33]); o.y = cvt_pk_bf16(s[2 * 33], s[3 * 33]); o.z = cvt_pk_bf16(s[4 * 33], s[5 * 33]); o.w = cvt_pk_bf16(s[6 * 33], s[7 * 33]);
        *(u32x4*)(WT + (size_t)(row0 + n) * ldk + dk0 + 8 * c) = o; }
    asm volatile("s_waitcnt lgkmcnt(0)" ::: "memory");
}

struct Args { const float* in[21]; float* out; unsigned char* ws; };

template <int SET> __device__ __forceinline__ void convert_weights(const Args& a, LAS unsigned char* lds, int gw, int NGW, int lane, int wave);
__device__ __forceinline__ void prologue(const Args& a, LAS unsigned char* lds, int G) {
    LAUNDER_TID();
    unsigned char* ws = a.ws;
    float* mod = (float*)(ws + WS_MOD);
    {
        LAS float* sc = (LAS float*)lds; LAS float* red = (LAS float*)(lds + 16384);
        const float* c = a.in[1]; const float* aw = a.in[2]; const float* ab = a.in[3];
        for (int i = tid; i < 4096; i += 512) { const float v = c[i]; sc[i] = v / (1.0f + expf(-v)); }
        __syncthreads();
        for (int it = blockIdx.x; it < NMOD / 32; it += G) {
            const int j0 = 32 * it, kg = tid >> 5, jj = tid & 31;
            float a0 = 0.f, a1 = 0.f, a2 = 0.f, a3 = 0.f;
#pragma unroll 8
            for (int k = kg; k < DM; k += 16) { const float w = aw[(size_t)k * NMOD + j0 + jj]; a0 += sc[k] * w; a1 += sc[1024 + k] * w; a2 += sc[2048 + k] * w; a3 += sc[3072 + k] * w; }
            red[(kg * 4 + 0) * 32 + jj] = a0; red[(kg * 4 + 1) * 32 + jj] = a1; red[(kg * 4 + 2) * 32 + jj] = a2; red[(kg * 4 + 3) * 32 + jj] = a3;
            __syncthreads();
            if (tid < 128) { const int b = tid >> 5; float s = 0.f;
#pragma unroll
                for (int g2 = 0; g2 < 16; ++g2) s += red[(g2 * 4 + b) * 32 + jj];
                mod[(size_t)b * NMOD + j0 + jj] = s + ab[j0 + jj]; }
            __syncthreads();
        }
    }
    __syncthreads();
}
template <int SET>
__device__ __forceinline__ void convert_weights(const Args& a, LAS unsigned char* lds, int gw, int NGW, int lane, int wave) {
    unsigned char* ws = a.ws;
    {
        LAS float* scr = (LAS float*)(lds + wave * 16384);
        constexpr int I_GU = 16 * 176, I_D = 44 * 32, I_IN = 16 * 160, I_AB = 8 * 32, I_OUT = 16 * 32;
        constexpr int NSET = SET == 0 ? 2 * I_GU : SET == 1 ? I_D + I_IN + 2 * I_AB + I_OUT : I_D;
        for (int k = gw; k < NSET; k += NGW) {
            int r;
            if (SET == 0) r = k < I_GU ? k : k + I_D;
            else if (SET == 1) r = k < I_D ? I_GU + k : k + (2 * I_GU + I_D);
            else r = 2 * I_GU + I_D + k;
            if (r < 2 * (I_GU + I_D)) {
                const int f = r >= (I_GU + I_D); if (f) r -= (I_GU + I_D);
                if (r < I_GU) { const int kb = r / 176, db = r % 176, tile = db >> 3, wb = db & 7, half = wb >> 2, cc = 32 * (wb & 3);
                    const float* src = a.in[(f ? 17 : 5) + half]; bf16_t* dst = (bf16_t*)(ws + (f ? WS_WGU2 : WS_WGU1));
                    transpose_item(src, DFF, 128 * tile + cc, 64 * kb, dst, DM, 32 * db, 64 * kb, scr, lane); }
                else { r -= I_GU; const int kb = r / 32, db = r % 32; const float* src = a.in[f ? 19 : 7]; bf16_t* dst = (bf16_t*)(ws + (f ? WS_WD2 : WS_WD1));
                    transpose_item(src, DM, 32 * db, 64 * kb, dst, DFF, 32 * db, 64 * kb, scr, lane); }
                continue;
            }
            r -= 2 * (I_GU + I_D);
            if (r < I_IN) { const int kb = r / 160, db = r % 160, d0 = 32 * db; int sc0;
                if (d0 < 1536) sc0 = d0; else if (d0 < 3072) sc0 = d0 + 8; else { const int e = d0 - 3072; sc0 = 3080 + ((e >> 7) & 1) * 1024 + 128 * (e >> 8) + (e & 127); }
                transpose_item(a.in[9], INC, sc0, 64 * kb, (bf16_t*)(ws + WS_WIN), DM, d0, 64 * kb, scr, lane); continue; }
            r -= I_IN;
            if (r < 2 * I_AB) { const int part = r >= I_AB; if (part) r -= I_AB; const int kb = r / 32, db = r % 32;
                transpose_item(a.in[13 + part], DM, 32 * db, 64 * kb, (bf16_t*)(ws + WS_WAB), DM, 32 * db, 512 * part + 64 * kb, scr, lane); continue; }
            r -= 2 * I_AB;
            { const int kb = r / 32, db = r % 32; transpose_item(a.in[15], DM, 32 * db, 64 * kb, (bf16_t*)(ws + WS_WOUT), DM, 32 * db, 64 * kb, scr, lane); }
        }
    }
}

template <bool FORGET>
__device__ __forceinline__ void norm_phase(const float* xin, const float* gamma, const float* shift, const float* scale, bf16_t* out,
                                           const float* w_in, const float* forget_b, float* logf, LAS unsigned char* lds, int G) {
    LAUNDER_TID();
    LAS float* wf = (LAS float*)lds;
    if (FORGET) { for (int i = tid; i < 8192; i += 512) wf[i] = w_in[(size_t)(i >> 3) * INC + 1536 + (i & 7)]; __syncthreads(); }
    const int gw = blockIdx.x * 8 + wave, NGW = G * 8;
    for (int row = gw; row < T_TOK; row += NGW) {
        const int b = row >> 12; const float* xr = xin + (size_t)row * DM + 4 * lane;
        f32x4 v[4]; float ss = 0.f;
#pragma unroll
        for (int j = 0; j < 4; ++j) { v[j] = *(const f32x4*)(xr + 256 * j); ss += (v[j][0] * v[j][0] + v[j][1] * v[j][1]) + (v[j][2] * v[j][2] + v[j][3] * v[j][3]); }
        const float rstd = 1.0f / sqrtf(wave_sum(ss) * (1.0f / DM) + EPS);
        float fa[8];
        if (FORGET) {
#pragma unroll
            for (int q = 0; q < 8; ++q) fa[q] = 0.f;
        }
#pragma unroll
        for (int j = 0; j < 4; ++j) {
            const int col = 256 * j + 4 * lane;
            const f32x4 gm = *(const f32x4*)(gamma + col), sc = *(const f32x4*)(scale + (size_t)b * NMOD + col), sh = *(const f32x4*)(shift + (size_t)b * NMOD + col);
            const f32x4 hv = v[j] * rstd * gm * (1.0f + sc) + sh;
            u32x2 w; w.x = cvt_pk_bf16(hv[0], hv[1]); w.y = cvt_pk_bf16(hv[2], hv[3]);
            *(u32x2*)(out + (size_t)row * DM + col) = w;
            if (FORGET) {
#pragma unroll
                for (int e = 0; e < 4; ++e) { const f32x4 w0 = *(const LAS f32x4*)(wf + (col + e) * 8), w1 = *(const LAS f32x4*)(wf + (col + e) * 8 + 4);
#pragma unroll
                    for (int q = 0; q < 4; ++q) { fa[q] += hv[e] * w0[q]; fa[4 + q] += hv[e] * w1[q]; } }
            }
        }
        if (FORGET) {
            float mine = 0.f;
#pragma unroll
            for (int q = 0; q < 8; ++q) { const float s = wave_sum(fa[q]); if (lane == q) mine = s; }
            if (lane < 8) { const float z = mine + forget_b[lane];
                const float ls = z > 0.f ? -log1pf(expf(-z)) : z - log1pf(expf(z));
                logf[(size_t)row * 8 + lane] = ls; }
        }
    }
    if (FORGET) __syncthreads();
}

__device__ __forceinline__ void scan_phase(const float* logf, float* F2, LAS unsigned char* lds, int G) {
    LAUNDER_TID();
    LAS float* wt = (LAS float*)lds;
    for (int seq = blockIdx.x; seq < 32; seq += G) {
        const int b = seq >> 3, h = seq & 7, s0 = 8 * tid;
        float run[8]; float acc = 0.f;
#pragma unroll
        for (int e = 0; e < 8; ++e) { acc += logf[((size_t)b * SEQ + s0 + e) * 8 + h]; run[e] = acc; }
        float inc = acc;
#pragma unroll
        for (int o = 1; o < 64; o <<= 1) { const float t = __shfl_up(inc, o); if (lane >= o) inc += t; }
        if (lane == 63) wt[wave] = inc;
        __syncthreads();
        float off = inc - acc;
        for (int w2 = 0; w2 < wave; ++w2) off += wt[w2];
#pragma unroll
        for (int e = 0; e < 8; ++e) F2[(size_t)seq * SEQ + s0 + e] = (off + run[e]) * LOG2E;
        __syncthreads();
    }
}

__device__ __forceinline__ void fa_phase(const bf16_t* Hh, const float* wfg, const float* forget_b, float* logfT, LAS unsigned char* lds, int G) {
    LAUNDER_TID();
    LAS float* wf = (LAS float*)lds;
    for (int i = tid; i < 2048; i += 512) *(LAS f32x4*)(wf + 4 * i) = *(const f32x4*)(wfg + 4 * i);
    __syncthreads();
    const int gw = blockIdx.x * 8 + wave, NGW = G * 8;
    for (int row = gw; row < T_TOK; row += 2 * NGW) {
        const int row2 = row + NGW; const bool has2 = row2 < T_TOK; const int rb = has2 ? row2 : row;
        u32x4 ha[2], hb[2];
#pragma unroll
        for (int hh = 0; hh < 2; ++hh) { ha[hh] = *(const u32x4*)(Hh + (size_t)row * DM + 512 * hh + 8 * lane); hb[hh] = *(const u32x4*)(Hh + (size_t)rb * DM + 512 * hh + 8 * lane); }
        float fa[8], fb[8];
#pragma unroll
        for (int q = 0; q < 8; ++q) { fa[q] = 0.f; fb[q] = 0.f; }
#pragma unroll
        for (int hh = 0; hh < 2; ++hh) {
            const int col = 512 * hh + 8 * lane;
#pragma unroll
            for (int e = 0; e < 8; ++e) {
                const unsigned wa = ha[hh][e >> 1], wb = hb[hh][e >> 1];
                const float va = __uint_as_float((e & 1) ? (wa & 0xffff0000u) : (wa << 16)), vb = __uint_as_float((e & 1) ? (wb & 0xffff0000u) : (wb << 16));
                const f32x4 w0 = *(const LAS f32x4*)(wf + (col + e) * 8), w1 = *(const LAS f32x4*)(wf + (col + e) * 8 + 4);
#pragma unroll
                for (int q = 0; q < 4; ++q) { fa[q] += va * w0[q]; fa[4 + q] += va * w1[q]; fb[q] += vb * w0[q]; fb[4 + q] += vb * w1[q]; } }
        }
        float ma = 0.f, mb = 0.f;
#pragma unroll
        for (int q = 0; q < 8; ++q) { const float sa = wave_sum(fa[q]), sb = wave_sum(fb[q]); if (lane == q) { ma = sa; mb = sb; } }
        if (lane < 8) { const float fbias = forget_b[lane];
            { const float z = ma + fbias; logfT[((size_t)(row >> 12) * 8 + lane) * SEQ + (row & 4095)] = z > 0.f ? -log1pf(expf(-z)) : z - log1pf(expf(z)); }
            if (has2) { const float z = mb + fbias; logfT[((size_t)(row2 >> 12) * 8 + lane) * SEQ + (row2 & 4095)] = z > 0.f ? -log1pf(expf(-z)) : z - log1pf(expf(z)); } }
    }
    __syncthreads();
}
__device__ __forceinline__ void scan_block(const float* logf, int b, int h, LAS float* FL, LAS float* wt) {
    LAUNDER_TID();
    const int s0 = 8 * tid;
    float run[8]; float acc = 0.f;
    const float* lp = logf + ((size_t)b * 8 + h) * SEQ + s0; const f32x4 l0 = *(const f32x4*)lp, l1 = *(const f32x4*)(lp + 4);
#pragma unroll
    for (int e = 0; e < 8; ++e) { acc += (e < 4 ? l0[e & 3] : l1[e & 3]); run[e] = acc; }
    float inc = acc;
#pragma unroll
    for (int o = 1; o < 64; o <<= 1) { const float t = __shfl_up(inc, o); if (lane >= o) inc += t; }
    if (lane == 63) wt[wave] = inc;
    __syncthreads();
    float off = inc - acc;
    for (int w2 = 0; w2 < wave; ++w2) off += wt[w2];
#pragma unroll
    for (int e = 0; e < 8; ++e) FL[s0 + e] = (off + run[e]) * LOG2E;
    __syncthreads();
}

constexpr int AT_ROWB = 144, AT_K = 0, AT_V = 64 * AT_ROWB, AT_F = 2 * 64 * AT_ROWB, AT_SLOT = AT_F + 256, AT_TBL = 2 * AT_SLOT, AT_FL = 40960, AT_WT = AT_FL + 16384;
__device__ __forceinline__ float max3f(float a, float b, float c) { return __builtin_fmaxf(__builtin_fmaxf(a, b), c); }
__device__ __forceinline__ u32x4 f3split(float f) {
    const unsigned h = cvt_pk_bf16(f, 0.f) & 0xffffu; const float r1 = f - __uint_as_float(h << 16);
    const unsigned m = cvt_pk_bf16(r1, 0.f) & 0xffffu; const float r2 = r1 - __uint_as_float(m << 16);
    const unsigned l = cvt_pk_bf16(r2, 0.f) & 0xffffu;
    u32x4 w; w.x = h | (m << 16); w.y = l; w.z = 0u; w.w = 0u; return w; }
constexpr float AT_THR = 6.0f;
template <int MODE>
__device__ __forceinline__ void attn_unit(LAS unsigned char* lds, const bf16_t* Q, const bf16_t* K, const bf16_t* Vt, const LAS float* fg, const float* relb,
                                          bf16_t* O, int ocol, int b, int h, int qb) {
    LAUNDER_TID(); const int w = wave;
    const int q32 = lane & 31, hi = lane >> 5;
    const int q0 = qb * 256, qloc = q0 + 32 * w + q32;
    const size_t tokbase = (size_t)b * SEQ;
    bf16x8 qf[4];
    { const bf16_t* qp = Q + (tokbase + qloc) * 512 + h * 64 + hi * 8;
#pragma unroll
      for (int d0 = 0; d0 < 4; ++d0) qf[d0] = *(const bf16x8*)(qp + 16 * d0); }
    int t_lo, t_hi, wt_lo, wt_hi; const int cw = 4 * qb + (w >> 1);
    if (MODE == 0) { t_lo = 0; t_hi = 4 * qb + 3; wt_lo = 0; wt_hi = cw; }
    else { t_lo = 4 * qb - 8 > 0 ? 4 * qb - 8 : 0; t_hi = 4 * qb + 3; wt_lo = cw - 8 > 0 ? cw - 8 : 0; wt_hi = cw; }
    const int nt = t_hi - t_lo + 1, dir = (MODE == 0) ? -1 : 1, t0 = (MODE == 0) ? t_hi : t_lo;
    const int sr = tid >> 3, sch = tid & 7;
    const bf16_t* kg = K + (tokbase + sr) * 512 + h * 64 + sch * 8;
    const bf16_t* vg = Vt + ((size_t)(b * 8 + h) * 64 + sr) * SEQ + sch * 8;
    float fref = 0.f; if (MODE == 0) fref = fg[q0];
    const int sdst = sr * AT_ROWB + sch * 16;
    u32x4 kreg, vreg; float freg = 0.f;
    kreg = *(const u32x4*)(kg + (size_t)t0 * 64 * 512); vreg = *(const u32x4*)(vg + t0 * 64);
    if (MODE == 0 && tid < 64) freg = fref - fg[t0 * 64 + tid];
    *(LAS u32x4*)(lds + AT_K + sdst) = kreg; *(LAS u32x4*)(lds + AT_V + sdst) = vreg;
    if (MODE == 0 && tid < 64) *(LAS u32x4*)(lds + AT_K + tid * AT_ROWB + 128) = f3split(freg);
    if (MODE == 1) { for (int i = tid; i < 257; i += 512) *(LAS float*)(lds + AT_TBL + 4 * i) = relb[i] * LOG2E; }
    __syncthreads();
    float m = 0.f, l = 0.f; f32x16 o0, o1, negm; int first = 1;
#pragma unroll
    for (int r = 0; r < 16; ++r) { o0[r] = 0.f; o1[r] = 0.f; negm[r] = 0.f; }
    asm volatile("" : "+v"(negm));
    const int krow = (q32 & 0x13) | ((q32 & 4) << 1) | ((q32 & 8) >> 1);
    const short one_b = hi ? (short)0 : (short)0x3F80;
    const bf16x8 qx = (bf16x8){one_b, one_b, one_b, 0, 0, 0, 0, 0};
    for (int j = 0; j < nt; ++j) {
        const int t = t0 + dir * j, cur = j & 1;
        if (j + 1 < nt) { const int tn = t + dir; kreg = *(const u32x4*)(kg + (size_t)tn * 64 * 512); vreg = *(const u32x4*)(vg + tn * 64);
            if (MODE == 0 && tid < 64) freg = fref - fg[tn * 64 + tid]; }
        if (t >= wt_lo && t <= wt_hi) {
            const LAS unsigned char* Ks = lds + cur * AT_SLOT + AT_K; const LAS unsigned char* Vs = lds + cur * AT_SLOT + AT_V; const LAS float* Fs = (const LAS float*)(lds + cur * AT_SLOT + AT_F);
            f32x16 p0, p1;
            const LAS unsigned char* ka = Ks + krow * AT_ROWB + hi * 16;
            {   const bf16x8 a0 = *(const LAS bf16x8*)(ka), a1 = *(const LAS bf16x8*)(ka + 32 * AT_ROWB);
                p0 = __builtin_amdgcn_mfma_f32_32x32x16_bf16(a0, qf[0], negm, 0, 0, 0);
                p1 = __builtin_amdgcn_mfma_f32_32x32x16_bf16(a1, qf[0], negm, 0, 0, 0); }
#pragma unroll
            for (int d0 = 1; d0 < 4; ++d0) {
                const bf16x8 a0 = *(const LAS bf16x8*)(ka + 32 * d0), a1 = *(const LAS bf16x8*)(ka + 32 * AT_ROWB + 32 * d0);
                p0 = __builtin_amdgcn_mfma_f32_32x32x16_bf16(a0, qf[d0], p0, 0, 0, 0);
                p1 = __builtin_amdgcn_mfma_f32_32x32x16_bf16(a1, qf[d0], p1, 0, 0, 0);
            }
            if (MODE == 0) {
                {   const bf16x8 ax0 = *(const LAS bf16x8*)(ka + 128), ax1 = *(const LAS bf16x8*)(ka + 32 * AT_ROWB + 128);
                    p0 = __builtin_amdgcn_mfma_f32_32x32x16_bf16(ax0, qx, p0, 0, 0, 0);
                    p1 = __builtin_amdgcn_mfma_f32_32x32x16_bf16(ax1, qx, p1, 0, 0, 0); }
                if (64 * t + 63 > q0 + 32 * w) {
                    const int lim = qloc - 64 * t - 8 * hi;
#pragma unroll
                    for (int r = 0; r < 16; ++r) { const int kc = 16 * (r >> 3) + (r & 7); if (kc > lim) p0[r] = -1e30f; if (kc + 32 > lim) p1[r] = -1e30f; }
                }
            } else {
                const LAS float* tbl = (const LAS float*)(lds + AT_TBL);
                if (cw - t >= 3) { const float bc = tbl[256];
#pragma unroll
                    for (int r = 0; r < 16; ++r) { p0[r] += bc; p1[r] += bc; } }
                else { const int base = qloc - 64 * t - 8 * hi + 128;
#pragma unroll
                    for (int r = 0; r < 16; ++r) { const int kc = 16 * (r >> 3) + (r & 7);
                        int i0 = base - kc; i0 = i0 < 0 ? 0 : (i0 > 256 ? 256 : i0); int i1 = base - kc - 32; i1 = i1 < 0 ? 0 : (i1 > 256 ? 256 : i1);
                        p0[r] += tbl[i0]; p1[r] += tbl[i1]; } }
            }
            float ma = p0[0], mb = p1[0];
#pragma unroll
            for (int r = 1; r < 15; r += 2) { ma = max3f(ma, p0[r], p0[r + 1]); mb = max3f(mb, p1[r], p1[r + 1]); }
            float mt = __builtin_fmaxf(max3f(ma, mb, p0[15]), p1[15]);
            mt = __builtin_fmaxf(mt, __shfl_xor(mt, 32));
            if (first || __builtin_amdgcn_ballot_w64(mt > AT_THR) != 0ull) {
                const float d = first ? mt : __builtin_fmaxf(mt, 0.f);
                m += d;
#pragma unroll
                for (int r = 0; r < 16; ++r) { p0[r] -= d; p1[r] -= d; }
                if (!first) { const float alpha = __builtin_amdgcn_exp2f(-d); l *= alpha;
#pragma unroll
                    for (int r = 0; r < 16; ++r) { o0[r] *= alpha; o1[r] *= alpha; } }
#pragma unroll
                for (int r = 0; r < 16; ++r) negm[r] = -m;
                asm volatile("" : "+v"(negm));
                first = 0;
            }
            float ls0 = 0.f, ls1 = 0.f;
#pragma unroll
            for (int r = 0; r < 16; ++r) { p0[r] = __builtin_amdgcn_exp2f(p0[r]); p1[r] = __builtin_amdgcn_exp2f(p1[r]); ls0 += p0[r]; ls1 += p1[r]; }
            l += ls0 + ls1;
            const LAS unsigned char* va = Vs + q32 * AT_ROWB + hi * 16;
#pragma unroll
            for (int ph = 0; ph < 2; ++ph)
#pragma unroll
                for (int jj = 0; jj < 2; ++jj) {
                    u32x4 pw;
                    if (ph == 0) { pw.x = cvt_pk_bf16(p0[8 * jj + 0], p0[8 * jj + 1]); pw.y = cvt_pk_bf16(p0[8 * jj + 2], p0[8 * jj + 3]); pw.z = cvt_pk_bf16(p0[8 * jj + 4], p0[8 * jj + 5]); pw.w = cvt_pk_bf16(p0[8 * jj + 6], p0[8 * jj + 7]); }
                    else { pw.x = cvt_pk_bf16(p1[8 * jj + 0], p1[8 * jj + 1]); pw.y = cvt_pk_bf16(p1[8 * jj + 2], p1[8 * jj + 3]); pw.z = cvt_pk_bf16(p1[8 * jj + 4], p1[8 * jj + 5]); pw.w = cvt_pk_bf16(p1[8 * jj + 6], p1[8 * jj + 7]); }
                    const bf16x8 pb = __builtin_bit_cast(bf16x8, pw);
                    const bf16x8 v0 = *(const LAS bf16x8*)(va + 64 * ph + 32 * jj), v1 = *(const LAS bf16x8*)(va + 32 * AT_ROWB + 64 * ph + 32 * jj);
                    o0 = __builtin_amdgcn_mfma_f32_32x32x16_bf16(v0, pb, o0, 0, 0, 0);
                    o1 = __builtin_amdgcn_mfma_f32_32x32x16_bf16(v1, pb, o1, 0, 0, 0);
                }
        }
        if (j + 1 < nt) { const int nb = (cur ^ 1) * AT_SLOT;
            *(LAS u32x4*)(lds + nb + AT_K + sdst) = kreg; *(LAS u32x4*)(lds + nb + AT_V + sdst) = vreg;
            if (MODE == 0 && tid < 64) *(LAS u32x4*)(lds + nb + AT_K + tid * AT_ROWB + 128) = f3split(freg); }
        __syncthreads();
    }
    l += __shfl_xor(l, 32);
    const float inv = 1.0f / l;
    bf16_t* op = O + (tokbase + qloc) * DM + ocol + 4 * hi;
#pragma unroll
    for (int g = 0; g < 4; ++g) {
        u32x2 w0, w1;
        w0.x = cvt_pk_bf16(o0[4 * g] * inv, o0[4 * g + 1] * inv); w0.y = cvt_pk_bf16(o0[4 * g + 2] * inv, o0[4 * g + 3] * inv);
        w1.x = cvt_pk_bf16(o1[4 * g] * inv, o1[4 * g + 1] * inv); w1.y = cvt_pk_bf16(o1[4 * g + 2] * inv, o1[4 * g + 3] * inv);
        *(u32x2*)(op + 8 * g) = w0; *(u32x2*)(op + 32 + 8 * g) = w1;
    }
}

#define XB_TMO      128
#define XB_XCNT(j)  (256  + 64 * (j))
#define XB_XSUB(j)  (1280 + 64 * (j))
#define XB_XGEN(j)  (2304 + 64 * (j))
#define XB_TOP      3328
#define XB_TOPGEN   3392
#define XCD_BAR_WORDS 3456
#define XB_SPIN_CAP (1u << 18)

__device__ __forceinline__ unsigned xb_ld(unsigned* p)              { return __hip_atomic_load(p, __ATOMIC_RELAXED, __HIP_MEMORY_SCOPE_AGENT); }
__device__ __forceinline__ unsigned xb_add(unsigned* p, unsigned v) { return __hip_atomic_fetch_add(p, v, __ATOMIC_RELAXED, __HIP_MEMORY_SCOPE_AGENT); }
__device__ __forceinline__ unsigned xb_xcc_id() { return (unsigned)__builtin_amdgcn_s_getreg((3 << 11) | 20) & 0xFu; }
#define XB_SPIN(cond, bar) do { unsigned _sp = 0; while (cond) { __builtin_amdgcn_s_sleep(1); \
    if ((++_sp & 255u) == 0u) { if (xb_ld(&(bar)[XB_TMO])) break; if (_sp > XB_SPIN_CAP) { atomicAdd(&(bar)[XB_TMO], 1u); break; } } } } while (0)

struct XcdBarrier {
    unsigned* bar; unsigned x;
    volatile LAS unsigned* st;
};

__device__ __forceinline__ XcdBarrier xcd_barrier_post(unsigned* bar, volatile LAS unsigned* st) {
    XcdBarrier b; b.bar = bar; b.x = xb_xcc_id(); b.st = st;
    if (threadIdx.x == 0) (void)xb_add(&bar[XB_XCNT(b.x)], 1u);
    return b;
}
__device__ __forceinline__ void xcd_barrier_complete(unsigned* bar, unsigned x, unsigned& nloc, unsigned& nx) {
    const unsigned G = gridDim.x * gridDim.y * gridDim.z;
    unsigned sum, cnt, mine, sp = 0u;
    for (;;) {
        sum = 0u; cnt = 0u; mine = 0u;
#pragma unroll
        for (unsigned j = 0; j < 16; ++j) { const unsigned c = xb_ld(&bar[XB_XCNT(j)]); sum += c; cnt += (c > 0u) ? 1u : 0u; mine = (j == x) ? c : mine; }
        if (sum == G) break;
        __builtin_amdgcn_s_sleep(1);
        if ((++sp & 255u) == 0u) { if (xb_ld(&bar[XB_TMO])) break; if (sp > XB_SPIN_CAP) { atomicAdd(&bar[XB_TMO], 1u); break; } }
    }
    nloc = mine > 0u ? mine : 1u; nx = cnt > 0u ? cnt : 1u;
}

__device__ __forceinline__ void xcd_barrier(const XcdBarrier& b) {
    asm volatile("s_waitcnt vmcnt(0)" ::: "memory");
    __syncthreads();
    if (threadIdx.x == 0) {
        unsigned* bar = b.bar;
        __builtin_amdgcn_s_waitcnt(0);
        unsigned nloc = b.st[0], nx = b.st[1];
        if (nloc == 0u) { xcd_barrier_complete(bar, b.x, nloc, nx); b.st[0] = nloc; b.st[1] = nx; }
        const unsigned old = xb_add(&bar[XB_XSUB(b.x)], 1u);
        const unsigned gen = old / nloc;
        if (old + 1u == (gen + 1u) * nloc) {
            __builtin_amdgcn_fence(__ATOMIC_RELEASE, "agent");
            asm volatile("s_waitcnt vmcnt(0)" ::: "memory");
            const unsigned og = xb_add(&bar[XB_TOP], 1u);
            const unsigned tg = og / nx;
            if (og + 1u == (tg + 1u) * nx) xb_add(&bar[XB_TOPGEN], 1u);
            else XB_SPIN(xb_ld(&bar[XB_TOPGEN]) == tg, bar);
            __builtin_amdgcn_fence(__ATOMIC_ACQUIRE, "agent");
            xb_add(&bar[XB_XGEN(b.x)], 1u);
            asm volatile("s_waitcnt vmcnt(0)" ::: "memory");
        } else {
            XB_SPIN(xb_ld(&bar[XB_XGEN(b.x)]) == gen, bar);
            __builtin_amdgcn_fence(__ATOMIC_ACQUIRE, "agent");
            asm volatile("s_waitcnt vmcnt(0)" ::: "memory");
        }
    }
    __syncthreads();
}

__global__ void __launch_bounds__(512, 2) mega_fwd(Args a) {
    extern __shared__ __attribute__((aligned(16))) unsigned char lds_raw[];
    LAS unsigned char* lds = (LAS unsigned char*)lds_raw;
    cg::grid_group grid = cg::this_grid();
    if (threadIdx.x < 64) ((LAS unsigned*)(lds + 131072))[threadIdx.x] = 0u;
    if (blockIdx.x == 0) { for (int i = threadIdx.x; i < (int)(BAR_BYTES / 4); i += 512) ((unsigned*)(a.ws + WS_BAR))[i] = 0u; asm volatile("s_waitcnt vmcnt(0)" ::: "memory"); }
    __syncthreads();
    const int G = gridDim.x;
    const int vcu = (G % 8 == 0) ? ((int)blockIdx.x % 8) * (G / 8) + (int)blockIdx.x / 8 : (int)blockIdx.x;
    unsigned char* ws = a.ws;
    float* mod = (float*)(ws + WS_MOD); float* logf = (float*)(ws + WS_LOGF); float* F2 = (float*)(ws + WS_F2);
    bf16_t* H = (bf16_t*)(ws + WS_H); bf16_t* ACT = (bf16_t*)(ws + WS_ACT);
    const float* x = a.in[0]; float* out = a.out;
    constexpr bool AL = true, SP = true;

    for (int r_ = 0; r_ < R_P0; ++r_) prologue(a, lds, G);
    grid.sync();
    const XcdBarrier xbar = xcd_barrier_post((unsigned*)(a.ws + WS_BAR), (volatile LAS unsigned*)(lds + 131072));
    { const int gid = blockIdx.x * 512 + threadIdx.x;
      if (gid < 8192) { const int which = gid >> 12, bb = (gid >> 10) & 3, col = gid & 1023;
          ((float*)(ws + (which ? WS_GS3 : WS_GS2)))[bb * DM + col] = a.in[which ? 16 : 8][col] * (1.0f + mod[(size_t)bb * NMOD + (which ? 7 : 4) * DM + col]); }
      else if (gid < 16384) { const int i = gid - 8192; ((float*)(ws + WS_WF))[i] = a.in[9][(size_t)(i >> 3) * INC + 1536 + (i & 7)]; } }
    for (int r_ = 0; r_ < R_P1; ++r_) norm_phase<false>(x, a.in[4], mod + 0 * DM, mod + 1 * DM, H, nullptr, nullptr, nullptr, lds, G);
    { LAUNDER_TID(); convert_weights<0>(a, lds, (int)blockIdx.x * 8 + wave, G * 8, lane, wave); }
    xcd_barrier(xbar);
    if (PHMASK & 4) { pg8::Gemm g{H, (const bf16_t*)(ws + WS_WGU1), T_TOK, 2 * DFF, DM}; pg8::StaticOrderT<R_P2> S; S.init(T_TOK, 2 * DFF, G, (int)blockIdx.x);
      Epi<QSwiglu> E{{ACT}}; pg8::gemm_phase<Epi<QSwiglu>, pg8::StaticOrderT<R_P2>, AL, SP>(lds, g, S, E); }
    if (G == 256 && blockIdx.x >= 128) { LAUNDER_TID(); convert_weights<1>(a, lds, ((int)blockIdx.x - 128) * 8 + wave, 1024, lane, wave); }
    else if (G != 256) { LAUNDER_TID(); convert_weights<1>(a, lds, (int)blockIdx.x * 8 + wave, G * 8, lane, wave); }
    xcd_barrier(xbar);
    { pg8::Gemm g{ACT, (const bf16_t*)(ws + WS_WD1), T_TOK, DM, DFF}; pg8::StaticOrder S; S.init(T_TOK, DM, G, (int)blockIdx.x);
      EpiResNorm<0> E{x, out, mod + 2 * DM, 0.5f, H, (const float*)(ws + WS_GS2), mod + 3 * DM, nullptr, (float*)(ws + WS_XCH), (unsigned*)(ws + WS_CNT)};
      pg8::gemm_phase<EpiResNorm<0>, pg8::StaticOrder, false, SP>(lds, g, S, E); }
    xcd_barrier(xbar);
    if (PHMASK & 64) { pg8::Gemm g{H, (const bf16_t*)(ws + WS_WIN), T_TOK, 5120, DM}; pg8::StaticOrderT<R_P5> S; S.init(T_TOK, 5120, G, (int)blockIdx.x);
      Epi<QWin> E{{(bf16_t*)(ws + WS_QA), (bf16_t*)(ws + WS_KA), (bf16_t*)(ws + WS_VTA), (bf16_t*)(ws + WS_QB), (bf16_t*)(ws + WS_KB), (bf16_t*)(ws + WS_VTB),
                   (_Float16*)(ws + WS_RATIO), (_Float16*)(ws + WS_GB), a.in[11]}};
      pg8::gemm_phase<Epi<QWin>, pg8::StaticOrderT<R_P5>, AL, SP>(lds, g, S, E); }
    fa_phase(H, (const float*)(ws + WS_WF), a.in[10], logf, lds, G);
    xcd_barrier(xbar);
    if (PHMASK & 128) { bf16_t* ATT = (bf16_t*)(ws + WS_ATT);
      for (int i = vcu; i < 256 * ATT_REPS; i += G) {
          const int bh = (i & 255) >> 3, s = i & 7, b = bh >> 3, h = bh & 7;
          const LAS float* FL = (const LAS float*)(lds + AT_FL);
          scan_block(logf, b, h, (LAS float*)(lds + AT_FL), (LAS float*)(lds + AT_WT));
          attn_unit<0>(lds, (const bf16_t*)(ws + WS_QA), (const bf16_t*)(ws + WS_KA), (const bf16_t*)(ws + WS_VTA), FL, nullptr, ATT, h * 64, b, h, s);
          attn_unit<0>(lds, (const bf16_t*)(ws + WS_QA), (const bf16_t*)(ws + WS_KA), (const bf16_t*)(ws + WS_VTA), FL, nullptr, ATT, h * 64, b, h, 15 - s);
          attn_unit<1>(lds, (const bf16_t*)(ws + WS_QB), (const bf16_t*)(ws + WS_KB), (const bf16_t*)(ws + WS_VTB), FL, a.in[12] + h * 257, ATT, 512 + h * 64, b, h, 2 * s);
          attn_unit<1>(lds, (const bf16_t*)(ws + WS_QB), (const bf16_t*)(ws + WS_KB), (const bf16_t*)(ws + WS_VTB), FL, a.in[12] + h * 257, ATT, 512 + h * 64, b, h, 2 * s + 1);
      } }
    xcd_barrier(xbar);
    { pg8::Gemm g{(const bf16_t*)(ws + WS_ATT), (const bf16_t*)(ws + WS_WAB), T_TOK, DM, DM}; pg8::StaticOrderT<R_P7> S; S.init(T_TOK, DM, G, (int)blockIdx.x);
      Epi<QGate> E{{(const _Float16*)(ws + WS_RATIO), (const _Float16*)(ws + WS_GB), (bf16_t*)(ws + WS_M)}};
      pg8::gemm_phase<Epi<QGate>, pg8::StaticOrderT<R_P7>, AL, SP, 8>(lds, g, S, E); }
    xcd_barrier(xbar);
    { pg8::Gemm g{(const bf16_t*)(ws + WS_M), (const bf16_t*)(ws + WS_WOUT), T_TOK, DM, DM}; pg8::StaticOrder S; S.init(T_TOK, DM, G, (int)blockIdx.x);
      EpiResNorm<0> E{out, out, mod + 5 * DM, 1.0f, H, (const float*)(ws + WS_GS3), mod + 6 * DM, nullptr, (float*)(ws + WS_XCH) + 65536, (unsigned*)(ws + WS_CNT) + 1024};
      pg8::gemm_phase<EpiResNorm<0>, pg8::StaticOrder, false, SP>(lds, g, S, E); }
    xcd_barrier(xbar);
    if (PHMASK & 2048) { pg8::Gemm g{H, (const bf16_t*)(ws + WS_WGU2), T_TOK, 2 * DFF, DM}; pg8::StaticOrder S; S.init(T_TOK, 2 * DFF, G, (int)blockIdx.x);
      Epi<QSwiglu> E{{ACT}}; pg8::gemm_phase<Epi<QSwiglu>, pg8::StaticOrder, AL, SP>(lds, g, S, E); }
    if (G == 256 && blockIdx.x >= 128) { LAUNDER_TID(); convert_weights<2>(a, lds, ((int)blockIdx.x - 128) * 8 + wave, 1024, lane, wave); }
    else if (G != 256) { LAUNDER_TID(); convert_weights<2>(a, lds, (int)blockIdx.x * 8 + wave, G * 8, lane, wave); }
    xcd_barrier(xbar);
    {
      pg8::Gemm g{ACT, (const bf16_t*)(ws + WS_WD2), T_TOK, DM, DFF}; pg8::StaticOrder S; S.init(T_TOK, DM, G, (int)blockIdx.x);
      EpiResNorm<1> E{out, out, mod + 8 * DM, 0.5f, nullptr, nullptr, nullptr, a.in[20], (float*)(ws + WS_XCH) + 2 * 65536, (unsigned*)(ws + WS_CNT) + 2 * 1024};
      pg8::gemm_phase<EpiResNorm<1>, pg8::StaticOrder, false, SP>(lds, g, S, E); }
}

extern "C" void kernel_launch(void* const* d_in, const int* in_sizes, int n_in, void* d_out, int out_size, void* d_ws, size_t ws_size, hipStream_t stream) {
    static int grid = 0;
    if (grid == 0) {
        if (n_in != 21 || out_size != T_TOK * DM || ws_size < WS_END) { fprintf(stderr, "kernel_launch: unexpected shapes (n_in %d out %d ws %zu)\n", n_in, out_size, ws_size); grid = -1; return; }
        int dev = 0, cus = 0, per_cu = 0;
        hipGetDevice(&dev); hipDeviceGetAttribute(&cus, hipDeviceAttributeMultiprocessorCount, dev);
        hipFuncSetAttribute((const void*)mega_fwd, hipFuncAttributeMaxDynamicSharedMemorySize, LDS_BYTES);
        hipOccupancyMaxActiveBlocksPerMultiprocessor(&per_cu, (const void*)mega_fwd, 512, LDS_BYTES);
        if (per_cu < 1) per_cu = 1;
        (void)hipGetLastError();
        grid = cus * per_cu;
    }
    if (grid < 0) return;
    Args a{};
    for (int i = 0; i < 21; ++i) a.in[i] = (const float*)d_in[i];
    a.out = (float*)d_out; a.ws = (unsigned char*)d_ws;
    void* args[] = {&a};
    hipError_t e = hipLaunchCooperativeKernel((const void*)mega_fwd, dim3(grid), dim3(512), args, LDS_BYTES, stream);
    if (e != hipSuccess) fprintf(stderr, "cooperative launch failed: %s (grid %d)\n", hipGetErrorString(e), grid);
}
```

```cpp
#include <hip/hip_runtime.h>
#include <hip/hip_cooperative_groups.h>
#include <cstdio>
#include <cstdint>
namespace pg8 {
#define PG8_LAS __attribute__((address_space(3)))
typedef unsigned short bf16_t;
typedef short bf16x8 __attribute__((ext_vector_type(8)));
typedef float f32x4 __attribute__((ext_vector_type(4)));
typedef unsigned u32x4 __attribute__((ext_vector_type(4)));
constexpr int BM = 256, BK = 64, HALF = 128, HTB = HALF * BK * 2  , STAGE_BYTES = 8 * HTB, NXCD = 8, WGM = 2;

__host__ __device__ __forceinline__ int lds_byte(int r, int c) { const int st = (r >> 4) * 2 + (c >> 5), rr = r & 15, cc = c & 31, ob = rr * 64 + cc * 2; return st * 1024 + (ob ^ (((ob >> 9) & 1) << 5)); }
__host__ __device__ __forceinline__ void stage_rc(int b, int& R, int& C) { const int st = b / 1024, sb = b % 1024, swz = sb ^ (((sb >> 9) & 1) << 5); R = (st >> 1) * 16 + swz / 64; C = (st & 1) * 32 + (swz % 64) / 2; }
__host__ __device__ __forceinline__ int perm32(int rho) { const int n = rho >> 4, i = rho & 15; return 8 * (i >> 2) + 4 * n + (i & 3); }

struct Unit { int pm, pn; };
struct Gemm { const bf16_t* A; const bf16_t* Bt; int M, N, K; };

template <int REPS = 1> struct StaticOrderT {
    int nM, nN, nwg, G, c;
    __host__ __device__ void init(int M, int N, int G_, int c_) { nM = M / BM; nN = N / BM; nwg = nM * nN; G = G_; c = c_; }
    __host__ __device__ bool next(int i, Unit& u) const {
        const long L = (long)i * G + c; if (L >= (long)nwg * REPS) return false;
        int wgid = (REPS > 1) ? (int)(L % nwg) : (int)L; { const int q = nwg / NXCD, r = nwg % NXCD, xcd = wgid % NXCD, off = wgid / NXCD; wgid = (xcd < r ? xcd * (q + 1) : r * (q + 1) + (xcd - r) * q) + off; }
        const int nig = WGM * nN, gid = wgid / nig, fm = gid * WGM, gsz = (nM - fm) < WGM ? (nM - fm) : WGM;
        u.pm = fm + ((wgid % nig) % gsz); u.pn = (wgid % nig) / gsz; return true;
    }
    __device__ __forceinline__ void a_ready(const Unit&) const {}
    __device__ __forceinline__ void done(const Unit&) const {}
};
typedef StaticOrderT<1> StaticOrder;

__device__ __forceinline__ unsigned cvt_pk_bf16(float lo, float hi) { unsigned r; asm volatile("v_cvt_pk_bf16_f32 %0, %1, %2" : "=v"(r) : "v"(lo), "v"(hi)); return r; }
template <class Epi, class Sched, bool ALIGN_EPI = false, bool SP2 = false, int MIDT = 0>
__device__ __forceinline__ void gemm_phase(PG8_LAS unsigned char* lds, const Gemm g, const Sched& S, const Epi& E) {
    int tid_ = threadIdx.x; asm volatile("" : "+v"(tid_));
    const int tid = tid_, wid = __builtin_amdgcn_readfirstlane(tid >> 6), lane = tid & 63, wr = wid >> 2, wc = wid & 3, fr = lane & 15, fq = lane >> 4;
    const int K = g.K, nt = K / BK;
    unsigned voffA[2], voffB[2];
#pragma unroll
    for (int i = 0; i < 2; ++i) { int R, C; stage_rc(tid * 16 + i * 8192, R, C); const int Rb = Epi::PERM ? ((R & ~31) + perm32(R & 31)) : R;
        voffA[i] = (unsigned)(R * K + C) * 2u; voffB[i] = (unsigned)(Rb * K + C) * 2u; }
    const size_t kstep = (size_t)(BK * 2);
    const size_t hstep = (size_t)HALF * K * 2;
    const size_t tstep = 2 * hstep;
    const unsigned ldsw = (unsigned)wid * 1024u;
    const int aoff = lds_byte(wr * 64 + fr, fq * 8), boff = lds_byte(wc * 32 + fr, fq * 8);
#define PG8_SA(b, h) (((b) * 2 + (h)) * HTB)
#define PG8_SB(b, h) ((4 + (b) * 2 + (h)) * HTB)
#define PG8_STAGE(bufoff, gbase, voff) do { _Pragma("unroll") for (int _i = 0; _i < 2; ++_i) \
        __builtin_amdgcn_global_load_lds((const unsigned*)((const char*)(gbase) + (voff)[_i]), (PG8_LAS unsigned*)(lds + (bufoff) + ldsw + _i * 8192), 16, 0, 0); } while (0)
#define PG8_LDA(dst, b, h) do { _Pragma("unroll") for (int m = 0; m < 4; ++m) _Pragma("unroll") for (int k = 0; k < 2; ++k) dst[m][k] = *(const PG8_LAS bf16x8*)(lds + PG8_SA(b, h) + aoff + m * 2048 + k * 1024); } while (0)
#define PG8_LDB(dst, b, h) do { _Pragma("unroll") for (int n = 0; n < 2; ++n) _Pragma("unroll") for (int k = 0; k < 2; ++k) dst[n][k] = *(const PG8_LAS bf16x8*)(lds + PG8_SB(b, h) + boff + n * 2048 + k * 1024); } while (0)
#define PG8_MMA(ai, bj, At, Bt) do { __builtin_amdgcn_s_setprio(1); _Pragma("unroll") for (int m = 0; m < 4; ++m) _Pragma("unroll") for (int n = 0; n < 2; ++n) _Pragma("unroll") for (int k = 0; k < 2; ++k) \
        acc[ai][bj][m][n] = __builtin_amdgcn_mfma_f32_16x16x32_bf16(Bt[n][k], At[m][k], acc[ai][bj][m][n], 0, 0, 0); __builtin_amdgcn_s_setprio(0); } while (0)
#define PG8_WAIT_V(n) asm volatile("s_waitcnt vmcnt(" #n ")" ::: "memory")
#define PG8_WAIT_L(n) asm volatile("s_waitcnt lgkmcnt(" #n ")" ::: "memory")
#define PG8_BAR __builtin_amdgcn_s_barrier()
#define PG8_SCHED __builtin_amdgcn_sched_barrier(0)
    Unit cur, nxt; int ui = 0;
    if (!S.next(0, cur)) return;
    f32x4 acc[2][2][4][2];
#pragma unroll
    for (int a = 0; a < 2; ++a)
#pragma unroll
        for (int b = 0; b < 2; ++b)
#pragma unroll
            for (int m = 0; m < 4; ++m)
#pragma unroll
                for (int n = 0; n < 2; ++n) acc[a][b][m][n] = (f32x4){0.f, 0.f, 0.f, 0.f};
    bf16x8 At[4][2], B0[2][2], B1[2][2];
    const char* cA = (const char*)g.A + (size_t)cur.pm * tstep; const char* cB = (const char*)g.Bt + (size_t)cur.pn * tstep;
    S.a_ready(cur);
    if constexpr (SP2) {
        PG8_STAGE(PG8_SB(0, 0), cB, voffB); PG8_STAGE(PG8_SB(0, 1), cB + hstep, voffB); PG8_STAGE(PG8_SA(0, 0), cA, voffA); PG8_STAGE(PG8_SA(0, 1), cA + hstep, voffA);
        if (wr == 1) PG8_BAR;
        PG8_WAIT_V(2); PG8_BAR;
        PG8_STAGE(PG8_SB(1, 0), cB + kstep, voffB); PG8_STAGE(PG8_SA(1, 0), cA + kstep, voffA); PG8_STAGE(PG8_SB(1, 1), cB + hstep + kstep, voffB);
        PG8_WAIT_V(6); PG8_BAR;
    } else {
        PG8_STAGE(PG8_SB(0, 0), cB, voffB); PG8_STAGE(PG8_SA(0, 0), cA, voffA); PG8_STAGE(PG8_SB(0, 1), cB + hstep, voffB); PG8_STAGE(PG8_SA(0, 1), cA + hstep, voffA);
        if (wr == 1) PG8_BAR;
        PG8_WAIT_V(4); PG8_BAR;
        PG8_STAGE(PG8_SB(1, 0), cB + kstep, voffB); PG8_STAGE(PG8_SA(1, 0), cA + kstep, voffA); PG8_STAGE(PG8_SB(1, 1), cB + hstep + kstep, voffB);
        PG8_WAIT_V(6); PG8_BAR;
    }
    for (;;) {
        const bool has_next = S.next(ui + 1, nxt);
        const char* nA = has_next ? (const char*)g.A + (size_t)nxt.pm * tstep : cA; const char* nB = has_next ? (const char*)g.Bt + (size_t)nxt.pn * tstep : cB;
        for (int t = 0; t < nt; t += 2) {
            const bool last = (t == nt - 2);
            if constexpr (MIDT > 0) { if (t == MIDT) E.mid(acc, cur, wr, wc, fr, fq); }
            const char* a1 = cA + (size_t)(t + 1) * kstep;
            const char* a2 = last ? nA : cA + (size_t)(t + 2) * kstep; const char* b2 = last ? nB : cB + (size_t)(t + 2) * kstep;
            const char* a3 = a2 + kstep; const char* b3 = b2 + kstep;
            if (last && has_next) S.a_ready(nxt);
            if constexpr (SP2) {
            PG8_LDB(B0, 0, 0); PG8_LDB(B1, 0, 1); PG8_SCHED; PG8_LDA(At, 0, 0); PG8_STAGE(PG8_SA(1, 1), a1 + hstep, voffA);
            PG8_WAIT_V(8); PG8_WAIT_L(0); PG8_BAR; PG8_MMA(0, 0, At, B0); PG8_MMA(0, 1, At, B1); PG8_BAR; PG8_SCHED;
            PG8_LDA(At, 0, 1); PG8_STAGE(PG8_SB(0, 0), b2, voffB); PG8_STAGE(PG8_SB(0, 1), b2 + hstep, voffB); PG8_STAGE(PG8_SA(0, 0), a2, voffA);
            PG8_WAIT_V(8); PG8_WAIT_L(0); PG8_BAR; PG8_MMA(1, 0, At, B0); PG8_MMA(1, 1, At, B1); PG8_BAR; PG8_SCHED;
            PG8_LDB(B0, 1, 0); PG8_LDB(B1, 1, 1); PG8_SCHED; PG8_LDA(At, 1, 0); PG8_STAGE(PG8_SA(0, 1), a2 + hstep, voffA);
            PG8_WAIT_V(8); PG8_WAIT_L(0); PG8_BAR; PG8_MMA(0, 0, At, B0); PG8_MMA(0, 1, At, B1); PG8_BAR; PG8_SCHED;
            PG8_LDA(At, 1, 1); PG8_STAGE(PG8_SB(1, 0), b3, voffB); PG8_STAGE(PG8_SB(1, 1), b3 + hstep, voffB); PG8_STAGE(PG8_SA(1, 0), a3, voffA);
            PG8_WAIT_V(8); PG8_WAIT_L(0); PG8_BAR; PG8_MMA(1, 0, At, B0); PG8_MMA(1, 1, At, B1); PG8_BAR; PG8_SCHED;
            } else {
            PG8_LDB(B0, 0, 0); PG8_SCHED; PG8_LDA(At, 0, 0); PG8_STAGE(PG8_SA(1, 1), a1 + hstep, voffA);
            PG8_WAIT_L(8); PG8_BAR; PG8_WAIT_L(0); PG8_MMA(0, 0, At, B0); PG8_BAR; PG8_SCHED;
            PG8_LDB(B1, 0, 1); PG8_STAGE(PG8_SB(0, 0), b2, voffB);
            PG8_BAR; PG8_WAIT_L(0); PG8_MMA(0, 1, At, B1); PG8_BAR;
            PG8_LDA(At, 0, 1); PG8_STAGE(PG8_SA(0, 0), a2, voffA);
            PG8_BAR; PG8_WAIT_L(0); PG8_MMA(1, 0, At, B0); PG8_BAR; PG8_SCHED;
            PG8_STAGE(PG8_SB(0, 1), b2 + hstep, voffB);
            PG8_WAIT_V(6); PG8_BAR; PG8_MMA(1, 1, At, B1); PG8_BAR;
            PG8_LDB(B0, 1, 0); PG8_SCHED; PG8_LDA(At, 1, 0); PG8_STAGE(PG8_SA(0, 1), a2 + hstep, voffA);
            PG8_WAIT_L(8); PG8_BAR; PG8_WAIT_L(0); PG8_MMA(0, 0, At, B0); PG8_BAR; PG8_SCHED;
            PG8_LDB(B1, 1, 1); PG8_STAGE(PG8_SB(1, 0), b3, voffB);
            PG8_BAR; PG8_WAIT_L(0); PG8_MMA(0, 1, At, B1); PG8_BAR;
            PG8_LDA(At, 1, 1); PG8_STAGE(PG8_SA(1, 0), a3, voffA);
            PG8_BAR; PG8_WAIT_L(0); PG8_MMA(1, 0, At, B0); PG8_BAR; PG8_SCHED;
            PG8_STAGE(PG8_SB(1, 1), b3 + hstep, voffB);
            PG8_WAIT_V(6); PG8_BAR; PG8_MMA(1, 1, At, B1); PG8_BAR;
            }
        }
        if constexpr (ALIGN_EPI) { if (wr == 0) PG8_BAR; }
        if constexpr (!Epi::AFTER_DRAIN) { E(acc, cur, wr, wc, fr, fq); S.done(cur); }
        if (!has_next) break;
#pragma unroll
        for (int a = 0; a < 2; ++a)
#pragma unroll
            for (int b = 0; b < 2; ++b)
#pragma unroll
                for (int m = 0; m < 4; ++m)
#pragma unroll
                    for (int n = 0; n < 2; ++n) acc[a][b][m][n] = (f32x4){0.f, 0.f, 0.f, 0.f};
        cur = nxt; cA = nA; cB = nB; ++ui;
        if constexpr (ALIGN_EPI) { if (wr == 1) PG8_BAR; }
    }
    PG8_WAIT_V(0);
    if constexpr (!ALIGN_EPI) { if (wr == 0) PG8_BAR; }
    PG8_BAR;
    if constexpr (Epi::AFTER_DRAIN) { E.fused(acc, cur, wr, wc, fr, fq, lds, wid, lane); S.done(cur); }
#undef PG8_SA
#undef PG8_SB
#undef PG8_STAGE
#undef PG8_LDA
#undef PG8_LDB
#undef PG8_MMA
#undef PG8_WAIT_V
#undef PG8_WAIT_L
#undef PG8_BAR
#undef PG8_SCHED
}
}
namespace cg = cooperative_groups;
#define LAS __attribute__((address_space(3)))
using pg8::bf16_t; using pg8::bf16x8; using pg8::f32x4; using pg8::u32x4; using pg8::cvt_pk_bf16;
typedef float f32x16 __attribute__((ext_vector_type(16)));
typedef unsigned u32x2 __attribute__((ext_vector_type(2)));
typedef _Float16 h16x8 __attribute__((ext_vector_type(8)));

constexpr int T_TOK = 16384, DM = 1024, SEQ = 4096, DFF = 2816, NMOD = 9216, INC = 5128;
constexpr float LOG2E = 1.4426950408889634f, C2 = 0.125f * 1.4426950408889634f, EPS = 1e-6f;
constexpr size_t MiB = 1u << 20;
constexpr size_t WS_GS2 = 160 * 1024, WS_GS3 = 176 * 1024, WS_WF = 192 * 1024;
constexpr size_t WS_MOD = 0, WS_LOGF = 256 * 1024, WS_F2 = 768 * 1024, WS_BAR = 1536 * 1024, BAR_BYTES = 32768, WS_CNT = WS_BAR + 16384, WS_XCH = 768 * 1024;
constexpr size_t SZ_WGU = (size_t)5632 * 1024 * 2, SZ_WD = (size_t)1024 * 2816 * 2;
constexpr size_t WS_WGU1 = 2 * MiB, WS_WD1 = WS_WGU1 + SZ_WGU, WS_WGU2 = WS_WD1 + SZ_WD, WS_WD2 = WS_WGU2 + SZ_WGU, WS_WIN = WS_WD2 + SZ_WD;
constexpr size_t WS_WAB = WS_WIN + 10 * MiB, WS_WOUT = WS_WAB + 2 * MiB, WS_H = WS_WOUT + 2 * MiB;
static_assert(WS_H == 49 * MiB, "ws map");
constexpr size_t WS_ACT = 81 * MiB;
constexpr size_t WS_QA = 81 * MiB, WS_KA = 97 * MiB, WS_VTA = 113 * MiB, WS_QB = 129 * MiB, WS_KB = 145 * MiB, WS_VTB = 161 * MiB, WS_RATIO = 177 * MiB, WS_GB = 209 * MiB, WS_END = 241 * MiB;
constexpr size_t WS_ATT = WS_H, WS_M = WS_QA, WS_TMP = WS_VTA;
constexpr int LDS_BYTES = 131072 + 1024;
#ifndef PHMASK
#define PHMASK 0xFFFF
#endif
#ifndef ATT_REPS
#define ATT_REPS 1
#endif
#ifndef R_P2
#define R_P2 1
#endif
#ifndef R_P3
#define R_P3 1
#endif
#ifndef R_P5
#define R_P5 1
#endif
#ifndef R_P7
#define R_P7 1
#endif
#ifndef R_P0
#define R_P0 1
#endif
#ifndef R_P1
#define R_P1 1
#endif

#define LAUNDER_TID() int tid = threadIdx.x; asm volatile("" : "+v"(tid)); const int lane = tid & 63, wave = __builtin_amdgcn_readfirstlane(tid >> 6); (void)lane; (void)wave
__device__ __forceinline__ float wave_sum(float v) {
#pragma unroll
    for (int o = 1; o < 64; o <<= 1) v += __shfl_xor(v, o);
    return v;
}
__device__ __forceinline__ float silu_f(float x) { return x * __builtin_amdgcn_rcpf(1.0f + __builtin_amdgcn_exp2f(-x * LOG2E)); }

template <class Q> struct Epi {
    static constexpr bool PERM = true, AFTER_DRAIN = false; Q q;
    __device__ __forceinline__ void operator()(f32x4 (&acc)[2][2][4][2], const pg8::Unit& u, int wr, int wc, int fr, int fq) const {
        const int row0 = u.pm * 256 + wr * 64 + fr, c0 = wc * 32 + 8 * fq;
#pragma unroll
        for (int ai = 0; ai < 2; ++ai)
#pragma unroll
            for (int m = 0; m < 4; ++m) q.oct(row0 + ai * 128 + m * 16, u.pn, c0, acc[ai][0][m][0], acc[ai][0][m][1], acc[ai][1][m][0], acc[ai][1][m][1]);
    }
    __device__ __forceinline__ void mid(f32x4 (&acc)[2][2][4][2], const pg8::Unit& u, int wr, int wc, int fr, int fq) const {
        const int row0 = u.pm * 256 + wr * 64 + fr, c0 = wc * 32 + 8 * fq;
#pragma unroll
        for (int ai = 0; ai < 2; ++ai)
#pragma unroll
            for (int m = 0; m < 4; ++m) { q.mid(row0 + ai * 128 + m * 16, u.pn, c0, acc[ai][0][m][0], acc[ai][0][m][1], acc[ai][1][m][0], acc[ai][1][m][1]); asm volatile("" ::: "memory"); }
    }
};
__device__ __forceinline__ u32x4 pack8(f32x4 lo, f32x4 hi) { u32x4 w; w.x = cvt_pk_bf16(lo[0], lo[1]); w.y = cvt_pk_bf16(lo[2], lo[3]); w.z = cvt_pk_bf16(hi[0], hi[1]); w.w = cvt_pk_bf16(hi[2], hi[3]); return w; }

struct QSwiglu {
    bf16_t* O;
    __device__ __forceinline__ void oct(int row, int pn, int c0, f32x4 a0, f32x4 a1, f32x4 b0, f32x4 b1) const {
        f32x4 lo, hi;
#pragma unroll
        for (int i = 0; i < 4; ++i) { lo[i] = silu_f(a0[i]) * b0[i]; hi[i] = silu_f(a1[i]) * b1[i]; }
        *(u32x4*)(O + (size_t)row * DFF + pn * 128 + c0) = pack8(lo, hi);
    }
    __device__ __forceinline__ void mid(int, int, int, f32x4&, f32x4&, f32x4&, f32x4&) const {}
};
struct QResid {
    const float* base; float* out; const float* g; float coef;
    __device__ __forceinline__ void oct(int row, int pn, int c0, f32x4 a0, f32x4 a1, f32x4 b0, f32x4 b1) const {
        const int b = row >> 12; const float* gp = g + (size_t)b * NMOD + pn * 256 + c0; const size_t off = (size_t)row * DM + pn * 256 + c0;
        const f32x4 g0 = *(const f32x4*)gp, g1 = *(const f32x4*)(gp + 4), g2 = *(const f32x4*)(gp + 128), g3 = *(const f32x4*)(gp + 132);
        const f32x4 x0 = *(const f32x4*)(base + off), x1 = *(const f32x4*)(base + off + 4), x2 = *(const f32x4*)(base + off + 128), x3 = *(const f32x4*)(base + off + 132);
        *(f32x4*)(out + off) = x0 + coef * g0 * a0; *(f32x4*)(out + off + 4) = x1 + coef * g1 * a1;
        *(f32x4*)(out + off + 128) = x2 + coef * g2 * b0; *(f32x4*)(out + off + 132) = x3 + coef * g3 * b1;
    }
    __device__ __forceinline__ void mid(int, int, int, f32x4&, f32x4&, f32x4&, f32x4&) const {}
};
struct QWin {
    bf16_t *QA, *KA, *VTA, *QB, *KB, *VTB; _Float16 *RATIO, *GB; const float* bgate;
    __device__ __forceinline__ void oct(int row, int pn, int c0, f32x4 a0, f32x4 a1, f32x4 b0, f32x4 b1) const {
        if (pn < 12) {
            const int kind = pn >> 1, colb = 256 * (pn & 1) + c0;
            if (kind == 2 || kind == 5) {
                bf16_t* VT = (kind == 2) ? VTA : VTB; const int b = row >> 12, s = row & 4095;
#pragma unroll
                for (int i = 0; i < 8; ++i) {
                    const float va = i < 4 ? a0[i & 3] : a1[i & 3], vb = i < 4 ? b0[i & 3] : b1[i & 3];
                    const int ca = colb + i, cb = colb + 128 + i;
                    VT[((size_t)(b * 8 + (ca >> 6)) * 64 + (ca & 63)) * SEQ + s] = (bf16_t)(cvt_pk_bf16(va, 0.f) & 0xffffu);
                    VT[((size_t)(b * 8 + (cb >> 6)) * 64 + (cb & 63)) * SEQ + s] = (bf16_t)(cvt_pk_bf16(vb, 0.f) & 0xffffu);
                }
            } else {
                bf16_t* P = (kind == 0) ? QA : (kind == 1) ? KA : (kind == 3) ? QB : KB;
                const float sc = (kind == 0 || kind == 3) ? C2 : 1.0f;
                *(u32x4*)(P + (size_t)row * 512 + colb) = pack8(a0 * sc, a1 * sc);
                *(u32x4*)(P + (size_t)row * 512 + colb + 128) = pack8(b0 * sc, b1 * sc);
            }
        } else {
            const int col = 128 * (pn - 12) + c0;
            h16x8 r, gbv;
#pragma unroll
            for (int i = 0; i < 8; ++i) {
                const float za = (i < 4 ? a0[i & 3] : a1[i & 3]) + bgate[col + i], zb = (i < 4 ? b0[i & 3] : b1[i & 3]) + bgate[DM + col + i];
                const float ea = __builtin_amdgcn_exp2f(-za * LOG2E), eb = __builtin_amdgcn_exp2f(-zb * LOG2E);
                r[i] = (_Float16)((1.0f + eb) * __builtin_amdgcn_rcpf(1.0f + ea));
                gbv[i] = (_Float16)__builtin_amdgcn_rcpf(1.0f + eb);
            }
            *(h16x8*)(RATIO + (size_t)row * DM + col) = r; *(h16x8*)(GB + (size_t)row * DM + col) = gbv;
        }
    }
    __device__ __forceinline__ void mid(int, int, int, f32x4&, f32x4&, f32x4&, f32x4&) const {}
};
struct QGate1 {
    const _Float16* RATIO; float* TMP;
    __device__ __forceinline__ void oct(int row, int pn, int c0, f32x4 a0, f32x4 a1, f32x4 b0, f32x4 b1) const {
        const _Float16* rp = RATIO + (size_t)row * DM + pn * 256 + c0; const h16x8 r0 = *(const h16x8*)rp, r1 = *(const h16x8*)(rp + 128);
#pragma unroll
        for (int i = 0; i < 4; ++i) { a0[i] *= (float)r0[i]; a1[i] *= (float)r0[4 + i]; b0[i] *= (float)r1[i]; b1[i] *= (float)r1[4 + i]; }
        float* tp = TMP + (size_t)row * DM + pn * 256 + c0;
        *(f32x4*)tp = a0; *(f32x4*)(tp + 4) = a1; *(f32x4*)(tp + 128) = b0; *(f32x4*)(tp + 132) = b1;
    }
    __device__ __forceinline__ void mid(int, int, int, f32x4&, f32x4&, f32x4&, f32x4&) const {}
};
struct QGate2 {
    const _Float16* GB; const float* TMP; bf16_t* M;
    __device__ __forceinline__ void oct(int row, int pn, int c0, f32x4 a0, f32x4 a1, f32x4 b0, f32x4 b1) const {
        const _Float16* rp = GB + (size_t)row * DM + pn * 256 + c0; const h16x8 r0 = *(const h16x8*)rp, r1 = *(const h16x8*)(rp + 128);
        const float* tp = TMP + (size_t)row * DM + pn * 256 + c0;
        a0 += *(const f32x4*)tp; a1 += *(const f32x4*)(tp + 4); b0 += *(const f32x4*)(tp + 128); b1 += *(const f32x4*)(tp + 132);
#pragma unroll
        for (int i = 0; i < 4; ++i) { a0[i] *= (float)r0[i]; a1[i] *= (float)r0[4 + i]; b0[i] *= (float)r1[i]; b1[i] *= (float)r1[4 + i]; }
        bf16_t* mp = M + (size_t)row * DM + pn * 256 + c0;
        *(u32x4*)mp = pack8(a0, a1); *(u32x4*)(mp + 128) = pack8(b0, b1);
    }
    __device__ __forceinline__ void mid(int, int, int, f32x4&, f32x4&, f32x4&, f32x4&) const {}
};

struct QGate {
    const _Float16* RATIO; const _Float16* GB; bf16_t* M;
    __device__ __forceinline__ void mid(int row, int pn, int c0, f32x4& a0, f32x4& a1, f32x4& b0, f32x4& b1) const {
        const unsigned off = ((unsigned)row * DM + (unsigned)(pn * 256 + c0)) * 2u;
        const h16x8 r0 = *(const h16x8*)((const char*)RATIO + off), r1 = *(const h16x8*)((const char*)RATIO + off + 256);
#pragma unroll
        for (int i = 0; i < 4; ++i) { a0[i] *= (float)r0[i]; a1[i] *= (float)r0[4 + i]; b0[i] *= (float)r1[i]; b1[i] *= (float)r1[4 + i]; }
    }
    __device__ __forceinline__ void oct(int row, int pn, int c0, f32x4 a0, f32x4 a1, f32x4 b0, f32x4 b1) const {
        const _Float16* rp = GB + (size_t)row * DM + pn * 256 + c0; const h16x8 r0 = *(const h16x8*)rp, r1 = *(const h16x8*)(rp + 128);
#pragma unroll
        for (int i = 0; i < 4; ++i) { a0[i] *= (float)r0[i]; a1[i] *= (float)r0[4 + i]; b0[i] *= (float)r1[i]; b1[i] *= (float)r1[4 + i]; }
        bf16_t* mp = M + (size_t)row * DM + pn * 256 + c0;
        *(u32x4*)mp = pack8(a0, a1); *(u32x4*)(mp + 128) = pack8(b0, b1);
    }
};

template <int MODE> struct EpiResNorm {
    static constexpr bool PERM = true, AFTER_DRAIN = true;
    const float* base; float* xout; const float* g; float coef;
    bf16_t* H; const float* gs; const float* sh; const float* fin;
    float* xch; unsigned* cnt;
    __device__ __forceinline__ void fused(f32x4 (&acc)[2][2][4][2], const pg8::Unit& u, int wr, int wc, int fr, int fq, LAS unsigned char* lds, int wid, int lane) const {
        const int tid = wid * 64 + lane, c0 = wc * 32 + 8 * fq, b = (u.pm * 256) >> 12, colA = u.pn * 256 + c0, colB = colA + 128;
        LAS float* P = (LAS float*)lds; LAS float* S = (LAS float*)(lds + 4096);
        {
            const float* gp = g + (size_t)b * NMOD;
            const f32x4 g0 = *(const f32x4*)(gp + colA) * coef, g1 = *(const f32x4*)(gp + colA + 4) * coef, g2 = *(const f32x4*)(gp + colB) * coef, g3 = *(const f32x4*)(gp + colB + 4) * coef;
#pragma unroll
            for (int ai = 0; ai < 2; ++ai)
#pragma unroll
                for (int m = 0; m < 4; ++m) {
                    const int r = ai * 128 + wr * 64 + m * 16 + fr; const size_t off = (size_t)(u.pm * 256 + r) * DM;
                    const f32x4 x0 = *(const f32x4*)(base + off + colA) + g0 * acc[ai][0][m][0], x1 = *(const f32x4*)(base + off + colA + 4) + g1 * acc[ai][0][m][1];
                    const f32x4 x2 = *(const f32x4*)(base + off + colB) + g2 * acc[ai][1][m][0], x3 = *(const f32x4*)(base + off + colB + 4) + g3 * acc[ai][1][m][1];
                    acc[ai][0][m][0] = x0; acc[ai][0][m][1] = x1; acc[ai][1][m][0] = x2; acc[ai][1][m][1] = x3;
                    if (MODE == 0) { *(f32x4*)(xout + off + colA) = x0; *(f32x4*)(xout + off + colA + 4) = x1; *(f32x4*)(xout + off + colB) = x2; *(f32x4*)(xout + off + colB + 4) = x3; }
                    float ss = ((x0[0] * x0[0] + x0[1] * x0[1]) + (x0[2] * x0[2] + x0[3] * x0[3])) + ((x1[0] * x1[0] + x1[1] * x1[1]) + (x1[2] * x1[2] + x1[3] * x1[3]))
                             + ((x2[0] * x2[0] + x2[1] * x2[1]) + (x2[2] * x2[2] + x2[3] * x2[3])) + ((x3[0] * x3[0] + x3[1] * x3[1]) + (x3[2] * x3[2] + x3[3] * x3[3]));
                    ss += __shfl_xor(ss, 16); ss += __shfl_xor(ss, 32);
                    if (fq == 0) P[r * 4 + wc] = ss;
                    if (m & 1) asm volatile("" ::: "memory");
                }
        }
        __syncthreads();
        float* slot = xch + (size_t)(u.pm * 4) * 256;
        if (tid < 256) { const f32x4 p = *(const LAS f32x4*)(P + tid * 4); __hip_atomic_store(slot + u.pn * 256 + tid, (p[0] + p[1]) + (p[2] + p[3]), __ATOMIC_RELAXED, __HIP_MEMORY_SCOPE_AGENT);
            asm volatile("s_waitcnt vmcnt(0)" ::: "memory");
            if (lane == 0) __hip_atomic_fetch_add(cnt + 16 * u.pm, 1u, __ATOMIC_RELAXED, __HIP_MEMORY_SCOPE_AGENT); }
        if (wid == 0) {
            unsigned* c = cnt + 16 * u.pm; unsigned spins = 0;
            while ((unsigned)__builtin_amdgcn_readfirstlane(__hip_atomic_load(c, __ATOMIC_RELAXED, __HIP_MEMORY_SCOPE_AGENT)) < 16u) { __builtin_amdgcn_s_sleep(2); if (++spins > (1u << 22)) break; }
            __builtin_amdgcn_fence(__ATOMIC_ACQUIRE, "agent");
        }
        asm volatile("s_waitcnt vmcnt(0) lgkmcnt(0)" ::: "memory");
        __syncthreads();
        if (tid < 256) {
            const float t = (__hip_atomic_load(slot + tid, __ATOMIC_RELAXED, __HIP_MEMORY_SCOPE_AGENT) + __hip_atomic_load(slot + 256 + tid, __ATOMIC_RELAXED, __HIP_MEMORY_SCOPE_AGENT))
                          + (__hip_atomic_load(slot + 512 + tid, __ATOMIC_RELAXED, __HIP_MEMORY_SCOPE_AGENT) + __hip_atomic_load(slot + 768 + tid, __ATOMIC_RELAXED, __HIP_MEMORY_SCOPE_AGENT));
            S[tid] = 1.0f / sqrtf(t * (1.0f / DM) + EPS);
        }
        __syncthreads();
        {
            f32x4 m0, m1, m2, m3, s0, s1, s2, s3;
            if (MODE == 1) { m0 = *(const f32x4*)(fin + colA); m1 = *(const f32x4*)(fin + colA + 4); m2 = *(const f32x4*)(fin + colB); m3 = *(const f32x4*)(fin + colB + 4); }
            else { const float* gq = gs + (size_t)b * DM; const float* sq = sh + (size_t)b * NMOD;
                m0 = *(const f32x4*)(gq + colA); m1 = *(const f32x4*)(gq + colA + 4); m2 = *(const f32x4*)(gq + colB); m3 = *(const f32x4*)(gq + colB + 4);
                s0 = *(const f32x4*)(sq + colA); s1 = *(const f32x4*)(sq + colA + 4); s2 = *(const f32x4*)(sq + colB); s3 = *(const f32x4*)(sq + colB + 4); }
#pragma unroll
            for (int ai = 0; ai < 2; ++ai)
#pragma unroll
                for (int m = 0; m < 4; ++m) {
                    const int r = ai * 128 + wr * 64 + m * 16 + fr; const size_t off = (size_t)(u.pm * 256 + r) * DM; const float rstd = S[r];
                    if (MODE == 1) {
                        *(f32x4*)(xout + off + colA) = acc[ai][0][m][0] * rstd * m0; *(f32x4*)(xout + off + colA + 4) = acc[ai][0][m][1] * rstd * m1;
                        *(f32x4*)(xout + off + colB) = acc[ai][1][m][0] * rstd * m2; *(f32x4*)(xout + off + colB + 4) = acc[ai][1][m][1] * rstd * m3;
                    } else {
                        *(u32x4*)(H + off + colA) = pack8(acc[ai][0][m][0] * rstd * m0 + s0, acc[ai][0][m][1] * rstd * m1 + s1);
                        *(u32x4*)(H + off + colB) = pack8(acc[ai][1][m][0] * rstd * m2 + s2, acc[ai][1][m][1] * rstd * m3 + s3);
                    }
                }
        }
    }
};

__device__ __forceinline__ void transpose_item(const float* W, int ldw, int n0, int k0, bf16_t* WT, int ldk, int row0, int dk0, LAS float* scr, int lane) {
    {
        const int r8 = lane >> 3, c4 = 4 * (lane & 7); f32x4 v[8];
#pragma unroll
        for (int i = 0; i < 8; ++i) v[i] = *(const f32x4*)(W + (size_t)(k0 + 8 * i + r8) * ldw + n0 + c4);
#pragma unroll
        for (int i = 0; i < 8; ++i) { LAS float* d = scr + (8 * i + r8) * 33 + c4; d[0] = v[i][0]; d[1] = v[i][1]; d[2] = v[i][2]; d[3] = v[i][3]; }
    }
    asm volatile("s_waitcnt lgkmcnt(0)" ::: "memory");
    const int c = lane & 7;
#pragma unroll
    for (int j = 0; j < 4; ++j) { const int n = (lane >> 3) + 8 * j; const LAS float* s = scr + (8 * c) * 33 + n;
        u32x4 o; o.x = cvt_pk_bf16(s[0 * 33], s[1 * 33]); o.y = cvt_pk_bf16(s[2 * 33], s[3 * 33]); o.z = cvt_pk_bf16(s[4 * 33], s[5 * 33]); o.w = cvt_pk_bf16(s[6 * 33], s[7 * 33]);
        *(u32x4*)(WT + (size_t)(row0 + n) * ldk + dk0 + 8 * c) = o; }
    asm volatile("s_waitcnt lgkmcnt(0)" ::: "memory");
}

struct Args { const float* in[21]; float* out; unsigned char* ws; };

template <int SET> __device__ __forceinline__ void convert_weights(const Args& a, LAS unsigned char* lds, int gw, int NGW, int lane, int wave);
__device__ __forceinline__ void prologue(const Args& a, LAS unsigned char* lds, int G) {
    LAUNDER_TID();
    unsigned char* ws = a.ws;
    float* mod = (float*)(ws + WS_MOD);
    {
        LAS float* sc = (LAS float*)lds; LAS float* red = (LAS float*)(lds + 16384);
        const float* c = a.in[1]; const float* aw = a.in[2]; const float* ab = a.in[3];
        for (int i = tid; i < 4096; i += 512) { const float v = c[i]; sc[i] = v / (1.0f + expf(-v)); }
        __syncthreads();
        for (int it = blockIdx.x; it < NMOD / 32; it += G) {
            const int j0 = 32 * it, kg = tid >> 5, jj = tid & 31;
            float a0 = 0.f, a1 = 0.f, a2 = 0.f, a3 = 0.f;
#pragma unroll 8
            for (int k = kg; k < DM; k += 16) { const float w = aw[(size_t)k * NMOD + j0 + jj]; a0 += sc[k] * w; a1 += sc[1024 + k] * w; a2 += sc[2048 + k] * w; a3 += sc[3072 + k] * w; }
            red[(kg * 4 + 0) * 32 + jj] = a0; red[(kg * 4 + 1) * 32 + jj] = a1; red[(kg * 4 + 2) * 32 + jj] = a2; red[(kg * 4 + 3) * 32 + jj] = a3;
            __syncthreads();
            if (tid < 128) { const int b = tid >> 5; float s = 0.f;
#pragma unroll
                for (int g2 = 0; g2 < 16; ++g2) s += red[(g2 * 4 + b) * 32 + jj];
                mod[(size_t)b * NMOD + j0 + jj] = s + ab[j0 + jj]; }
            __syncthreads();
        }
    }
    __syncthreads();
}
template <int SET>
__device__ __forceinline__ void convert_weights(const Args& a, LAS unsigned char* lds, int gw, int NGW, int lane, int wave) {
    unsigned char* ws = a.ws;
    {
        LAS float* scr = (LAS float*)(lds + wave * 16384);
        constexpr int I_GU = 16 * 176, I_D = 44 * 32, I_IN = 16 * 160, I_AB = 8 * 32, I_OUT = 16 * 32;
        constexpr int NSET = SET == 0 ? 2 * I_GU : SET == 1 ? I_D + I_IN + 2 * I_AB + I_OUT : I_D;
        for (int k = gw; k < NSET; k += NGW) {
            int r;
            if (SET == 0) r = k < I_GU ? k : k + I_D;
            else if (SET == 1) r = k < I_D ? I_GU + k : k + (2 * I_GU + I_D);
            else r = 2 * I_GU + I_D + k;
            if (r < 2 * (I_GU + I_D)) {
                const int f = r >= (I_GU + I_D); if (f) r -= (I_GU + I_D);
                if (r < I_GU) { const int kb = r / 176, db = r % 176, tile = db >> 3, wb = db & 7, half = wb >> 2, cc = 32 * (wb & 3);
                    const float* src = a.in[(f ? 17 : 5) + half]; bf16_t* dst = (bf16_t*)(ws + (f ? WS_WGU2 : WS_WGU1));
                    transpose_item(src, DFF, 128 * tile + cc, 64 * kb, dst, DM, 32 * db, 64 * kb, scr, lane); }
                else { r -= I_GU; const int kb = r / 32, db = r % 32; const float* src = a.in[f ? 19 : 7]; bf16_t* dst = (bf16_t*)(ws + (f ? WS_WD2 : WS_WD1));
                    transpose_item(src, DM, 32 * db, 64 * kb, dst, DFF, 32 * db, 64 * kb, scr, lane); }
                continue;
            }
            r -= 2 * (I_GU + I_D);
            if (r < I_IN) { const int kb = r / 160, db = r % 160, d0 = 32 * db; int sc0;
                if (d0 < 1536) sc0 = d0; else if (d0 < 3072) sc0 = d0 + 8; else { const int e = d0 - 3072; sc0 = 3080 + ((e >> 7) & 1) * 1024 + 128 * (e >> 8) + (e & 127); }
                transpose_item(a.in[9], INC, sc0, 64 * kb, (bf16_t*)(ws + WS_WIN), DM, d0, 64 * kb, scr, lane); continue; }
            r -= I_IN;
            if (r < 2 * I_AB) { const int part = r >= I_AB; if (part) r -= I_AB; const int kb = r / 32, db = r % 32;
                transpose_item(a.in[13 + part], DM, 32 * db, 64 * kb, (bf16_t*)(ws + WS_WAB), DM, 32 * db, 512 * part + 64 * kb, scr, lane); continue; }
            r -= 2 * I_AB;
            { const int kb = r / 32, db = r % 32; transpose_item(a.in[15], DM, 32 * db, 64 * kb, (bf16_t*)(ws + WS_WOUT), DM, 32 * db, 64 * kb, scr, lane); }
        }
    }
}

template <bool FORGET>
__device__ __forceinline__ void norm_phase(const float* xin, const float* gamma, const float* shift, const float* scale, bf16_t* out,
                                           const float* w_in, const float* forget_b, float* logf, LAS unsigned char* lds, int G) {
    LAUNDER_TID();
    LAS float* wf = (LAS float*)lds;
    if (FORGET) { for (int i = tid; i < 8192; i += 512) wf[i] = w_in[(size_t)(i >> 3) * INC + 1536 + (i & 7)]; __syncthreads(); }
    const int gw = blockIdx.x * 8 + wave, NGW = G * 8;
    for (int row = gw; row < T_TOK; row += NGW) {
        const int b = row >> 12; const float* xr = xin + (size_t)row * DM + 4 * lane;
        f32x4 v[4]; float ss = 0.f;
#pragma unroll
        for (int j = 0; j < 4; ++j) { v[j] = *(const f32x4*)(xr + 256 * j); ss += (v[j][0] * v[j][0] + v[j][1] * v[j][1]) + (v[j][2] * v[j][2] + v[j][3] * v[j][3]); }
        const float rstd = 1.0f / sqrtf(wave_sum(ss) * (1.0f / DM) + EPS);
        float fa[8];
        if (FORGET) {
#pragma unroll
            for (int q = 0; q < 8; ++q) fa[q] = 0.f;
        }
#pragma unroll
        for (int j = 0; j < 4; ++j) {
            const int col = 256 * j + 4 * lane;
            const f32x4 gm = *(const f32x4*)(gamma + col), sc = *(const f32x4*)(scale + (size_t)b * NMOD + col), sh = *(const f32x4*)(shift + (size_t)b * NMOD + col);
            const f32x4 hv = v[j] * rstd * gm * (1.0f + sc) + sh;
            u32x2 w; w.x = cvt_pk_bf16(hv[0], hv[1]); w.y = cvt_pk_bf16(hv[2], hv[3]);
            *(u32x2*)(out + (size_t)row * DM + col) = w;
            if (FORGET) {
#pragma unroll
                for (int e = 0; e < 4; ++e) { const f32x4 w0 = *(const LAS f32x4*)(wf + (col + e) * 8), w1 = *(const LAS f32x4*)(wf + (col + e) * 8 + 4);
#pragma unroll
                    for (int q = 0; q < 4; ++q) { fa[q] += hv[e] * w0[q]; fa[4 + q] += hv[e] * w1[q]; } }
            }
        }
        if (FORGET) {
            float mine = 0.f;
#pragma unroll
            for (int q = 0; q < 8; ++q) { const float s = wave_sum(fa[q]); if (lane == q) mine = s; }
            if (lane < 8) { const float z = mine + forget_b[lane];
                const float ls = z > 0.f ? -log1pf(expf(-z)) : z - log1pf(expf(z));
                logf[(size_t)row * 8 + lane] = ls; }
        }
    }
    if (FORGET) __syncthreads();
}

__device__ __forceinline__ void scan_phase(const float* logf, float* F2, LAS unsigned char* lds, int G) {
    LAUNDER_TID();
    LAS float* wt = (LAS float*)lds;
    for (int seq = blockIdx.x; seq < 32; seq += G) {
        const int b = seq >> 3, h = seq & 7, s0 = 8 * tid;
        float run[8]; float acc = 0.f;
#pragma unroll
        for (int e = 0; e < 8; ++e) { acc += logf[((size_t)b * SEQ + s0 + e) * 8 + h]; run[e] = acc; }
        float inc = acc;
#pragma unroll
        for (int o = 1; o < 64; o <<= 1) { const float t = __shfl_up(inc, o); if (lane >= o) inc += t; }
        if (lane == 63) wt[wave] = inc;
        __syncthreads();
        float off = inc - acc;
        for (int w2 = 0; w2 < wave; ++w2) off += wt[w2];
#pragma unroll
        for (int e = 0; e < 8; ++e) F2[(size_t)seq * SEQ + s0 + e] = (off + run[e]) * LOG2E;
        __syncthreads();
    }
}

__device__ __forceinline__ void fa_phase(const bf16_t* Hh, const float* wfg, const float* forget_b, float* logfT, LAS unsigned char* lds, int G) {
    LAUNDER_TID();
    LAS float* wf = (LAS float*)lds;
    for (int i = tid; i < 2048; i += 512) *(LAS f32x4*)(wf + 4 * i) = *(const f32x4*)(wfg + 4 * i);
    __syncthreads();
    const int gw = blockIdx.x * 8 + wave, NGW = G * 8;
    for (int row = gw; row < T_TOK; row += 2 * NGW) {
        const int row2 = row + NGW; const bool has2 = row2 < T_TOK; const int rb = has2 ? row2 : row;
        u32x4 ha[2], hb[2];
#pragma unroll
        for (int hh = 0; hh < 2; ++hh) { ha[hh] = *(const u32x4*)(Hh + (size_t)row * DM + 512 * hh + 8 * lane); hb[hh] = *(const u32x4*)(Hh + (size_t)rb * DM + 512 * hh + 8 * lane); }
        float fa[8], fb[8];
#pragma unroll
        for (int q = 0; q < 8; ++q) { fa[q] = 0.f; fb[q] = 0.f; }
#pragma unroll
        for (int hh = 0; hh < 2; ++hh) {
            const int col = 512 * hh + 8 * lane;
#pragma unroll
            for (int e = 0; e < 8; ++e) {
                const unsigned wa = ha[hh][e >> 1], wb = hb[hh][e >> 1];
                const float va = __uint_as_float((e & 1) ? (wa & 0xffff0000u) : (wa << 16)), vb = __uint_as_float((e & 1) ? (wb & 0xffff0000u) : (wb << 16));
                const f32x4 w0 = *(const LAS f32x4*)(wf + (col + e) * 8), w1 = *(const LAS f32x4*)(wf + (col + e) * 8 + 4);
#pragma unroll
                for (int q = 0; q < 4; ++q) { fa[q] += va * w0[q]; fa[4 + q] += va * w1[q]; fb[q] += vb * w0[q]; fb[4 + q] += vb * w1[q]; } }
        }
        float ma = 0.f, mb = 0.f;
#pragma unroll
        for (int q = 0; q < 8; ++q) { const float sa = wave_sum(fa[q]), sb = wave_sum(fb[q]); if (lane == q) { ma = sa; mb = sb; } }
        if (lane < 8) { const float fbias = forget_b[lane];
            { const float z = ma + fbias; logfT[((size_t)(row >> 12) * 8 + lane) * SEQ + (row & 4095)] = z > 0.f ? -log1pf(expf(-z)) : z - log1pf(expf(z)); }
            if (has2) { const float z = mb + fbias; logfT[((size_t)(row2 >> 12) * 8 + lane) * SEQ + (row2 & 4095)] = z > 0.f ? -log1pf(expf(-z)) : z - log1pf(expf(z)); } }
    }
    __syncthreads();
}
__device__ __forceinline__ void scan_block(const float* logf, int b, int h, LAS float* FL, LAS float* wt) {
    LAUNDER_TID();
    const int s0 = 8 * tid;
    float run[8]; float acc = 0.f;
    const float* lp = logf + ((size_t)b * 8 + h) * SEQ + s0; const f32x4 l0 = *(const f32x4*)lp, l1 = *(const f32x4*)(lp + 4);
#pragma unroll
    for (int e = 0; e < 8; ++e) { acc += (e < 4 ? l0[e & 3] : l1[e & 3]); run[e] = acc; }
    float inc = acc;
#pragma unroll
    for (int o = 1; o < 64; o <<= 1) { const float t = __shfl_up(inc, o); if (lane >= o) inc += t; }
    if (lane == 63) wt[wave] = inc;
    __syncthreads();
    float off = inc - acc;
    for (int w2 = 0; w2 < wave; ++w2) off += wt[w2];
#pragma unroll
    for (int e = 0; e < 8; ++e) FL[s0 + e] = (off + run[e]) * LOG2E;
    __syncthreads();
}

constexpr int AT_ROWB = 144, AT_K = 0, AT_V = 64 * AT_ROWB, AT_F = 2 * 64 * AT_ROWB, AT_SLOT = AT_F + 256, AT_TBL = 2 * AT_SLOT, AT_FL = 40960, AT_WT = AT_FL + 16384;
__device__ __forceinline__ float max3f(float a, float b, float c) { return __builtin_fmaxf(__builtin_fmaxf(a, b), c); }
__device__ __forceinline__ u32x4 f3split(float f) {
    const unsigned h = cvt_pk_bf16(f, 0.f) & 0xffffu; const float r1 = f - __uint_as_float(h << 16);
    const unsigned m = cvt_pk_bf16(r1, 0.f) & 0xffffu; const float r2 = r1 - __uint_as_float(m << 16);
    const unsigned l = cvt_pk_bf16(r2, 0.f) & 0xffffu;
    u32x4 w; w.x = h | (m << 16); w.y = l; w.z = 0u; w.w = 0u; return w; }
constexpr float AT_THR = 6.0f;
template <int MODE>
__device__ __forceinline__ void attn_unit(LAS unsigned char* lds, const bf16_t* Q, const bf16_t* K, const bf16_t* Vt, const LAS float* fg, const float* relb,
                                          bf16_t* O, int ocol, int b, int h, int qb) {
    LAUNDER_TID(); const int w = wave;
    const int q32 = lane & 31, hi = lane >> 5;
    const int q0 = qb * 256, qloc = q0 + 32 * w + q32;
    const size_t tokbase = (size_t)b * SEQ;
    bf16x8 qf[4];
    { const bf16_t* qp = Q + (tokbase + qloc) * 512 + h * 64 + hi * 8;
#pragma unroll
      for (int d0 = 0; d0 < 4; ++d0) qf[d0] = *(const bf16x8*)(qp + 16 * d0); }
    int t_lo, t_hi, wt_lo, wt_hi; const int cw = 4 * qb + (w >> 1);
    if (MODE == 0) { t_lo = 0; t_hi = 4 * qb + 3; wt_lo = 0; wt_hi = cw; }
    else { t_lo = 4 * qb - 8 > 0 ? 4 * qb - 8 : 0; t_hi = 4 * qb + 3; wt_lo = cw - 8 > 0 ? cw - 8 : 0; wt_hi = cw; }
    const int nt = t_hi - t_lo + 1, dir = (MODE == 0) ? -1 : 1, t0 = (MODE == 0) ? t_hi : t_lo;
    const int sr = tid >> 3, sch = tid & 7;
    const bf16_t* kg = K + (tokbase + sr) * 512 + h * 64 + sch * 8;
    const bf16_t* vg = Vt + ((size_t)(b * 8 + h) * 64 + sr) * SEQ + sch * 8;
    float fref = 0.f; if (MODE == 0) fref = fg[q0];
    const int sdst = sr * AT_ROWB + sch * 16;
    u32x4 kreg, vreg; float freg = 0.f;
    kreg = *(const u32x4*)(kg + (size_t)t0 * 64 * 512); vreg = *(const u32x4*)(vg + t0 * 64);
    if (MODE == 0 && tid < 64) freg = fref - fg[t0 * 64 + tid];
    *(LAS u32x4*)(lds + AT_K + sdst) = kreg; *(LAS u32x4*)(lds + AT_V + sdst) = vreg;
    if (MODE == 0 && tid < 64) *(LAS u32x4*)(lds + AT_K + tid * AT_ROWB + 128) = f3split(freg);
    if (MODE == 1) { for (int i = tid; i < 257; i += 512) *(LAS float*)(lds + AT_TBL + 4 * i) = relb[i] * LOG2E; }
    __syncthreads();
    float m = 0.f, l = 0.f; f32x16 o0, o1, negm; int first = 1;
#pragma unroll
    for (int r = 0; r < 16; ++r) { o0[r] = 0.f; o1[r] = 0.f; negm[r] = 0.f; }
    asm volatile("" : "+v"(negm));
    const int krow = (q32 & 0x13) | ((q32 & 4) << 1) | ((q32 & 8) >> 1);
    const short one_b = hi ? (short)0 : (short)0x3F80;
    const bf16x8 qx = (bf16x8){one_b, one_b, one_b, 0, 0, 0, 0, 0};
    for (int j = 0; j < nt; ++j) {
        const int t = t0 + dir * j, cur = j & 1;
        if (j + 1 < nt) { const int tn = t + dir; kreg = *(const u32x4*)(kg + (size_t)tn * 64 * 512); vreg = *(const u32x4*)(vg + tn * 64);
            if (MODE == 0 && tid < 64) freg = fref - fg[tn * 64 + tid]; }
        if (t >= wt_lo && t <= wt_hi) {
            const LAS unsigned char* Ks = lds + cur * AT_SLOT + AT_K; const LAS unsigned char* Vs = lds + cur * AT_SLOT + AT_V; const LAS float* Fs = (const LAS float*)(lds + cur * AT_SLOT + AT_F);
            f32x16 p0, p1;
            const LAS unsigned char* ka = Ks + krow * AT_ROWB + hi * 16;
            {   const bf16x8 a0 = *(const LAS bf16x8*)(ka), a1 = *(const LAS bf16x8*)(ka + 32 * AT_ROWB);
                p0 = __builtin_amdgcn_mfma_f32_32x32x16_bf16(a0, qf[0], negm, 0, 0, 0);
                p1 = __builtin_amdgcn_mfma_f32_32x32x16_bf16(a1, qf[0], negm, 0, 0, 0); }
#pragma unroll
            for (int d0 = 1; d0 < 4; ++d0) {
                const bf16x8 a0 = *(const LAS bf16x8*)(ka + 32 * d0), a1 = *(const LAS bf16x8*)(ka + 32 * AT_ROWB + 32 * d0);
                p0 = __builtin_amdgcn_mfma_f32_32x32x16_bf16(a0, qf[d0], p0, 0, 0, 0);
                p1 = __builtin_amdgcn_mfma_f32_32x32x16_bf16(a1, qf[d0], p1, 0, 0, 0);
            }
            if (MODE == 0) {
                {   const bf16x8 ax0 = *(const LAS bf16x8*)(ka + 128), ax1 = *(const LAS bf16x8*)(ka + 32 * AT_ROWB + 128);
                    p0 = __builtin_amdgcn_mfma_f32_32x32x16_bf16(ax0, qx, p0, 0, 0, 0);
                    p1 = __builtin_amdgcn_mfma_f32_32x32x16_bf16(ax1, qx, p1, 0, 0, 0); }
                if (64 * t + 63 > q0 + 32 * w) {
                    const int lim = qloc - 64 * t - 8 * hi;
#pragma unroll
                    for (int r = 0; r < 16; ++r) { const int kc = 16 * (r >> 3) + (r & 7); if (kc > lim) p0[r] = -1e30f; if (kc + 32 > lim) p1[r] = -1e30f; }
                }
            } else {
                const LAS float* tbl = (const LAS float*)(lds + AT_TBL);
                if (cw - t >= 3) { const float bc = tbl[256];
#pragma unroll
                    for (int r = 0; r < 16; ++r) { p0[r] += bc; p1[r] += bc; } }
                else { const int base = qloc - 64 * t - 8 * hi + 128;
#pragma unroll
                    for (int r = 0; r < 16; ++r) { const int kc = 16 * (r >> 3) + (r & 7);
                        int i0 = base - kc; i0 = i0 < 0 ? 0 : (i0 > 256 ? 256 : i0); int i1 = base - kc - 32; i1 = i1 < 0 ? 0 : (i1 > 256 ? 256 : i1);
                        p0[r] += tbl[i0]; p1[r] += tbl[i1]; } }
            }
            float ma = p0[0], mb = p1[0];
#pragma unroll
            for (int r = 1; r < 15; r += 2) { ma = max3f(ma, p0[r], p0[r + 1]); mb = max3f(mb, p1[r], p1[r + 1]); }
            float mt = __builtin_fmaxf(max3f(ma, mb, p0[15]), p1[15]);
            mt = __builtin_fmaxf(mt, __shfl_xor(mt, 32));
            if (first || __builtin_amdgcn_ballot_w64(mt > AT_THR) != 0ull) {
                const float d = first ? mt : __builtin_fmaxf(mt, 0.f);
                m += d;
#pragma unroll
                for (int r = 0; r < 16; ++r) { p0[r] -= d; p1[r] -= d; }
                if (!first) { const float alpha = __builtin_amdgcn_exp2f(-d); l *= alpha;
#pragma unroll
                    for (int r = 0; r < 16; ++r) { o0[r] *= alpha; o1[r] *= alpha; } }
#pragma unroll
                for (int r = 0; r < 16; ++r) negm[r] = -m;
                asm volatile("" : "+v"(negm));
                first = 0;
            }
            float ls0 = 0.f, ls1 = 0.f;
#pragma unroll
            for (int r = 0; r < 16; ++r) { p0[r] = __builtin_amdgcn_exp2f(p0[r]); p1[r] = __builtin_amdgcn_exp2f(p1[r]); ls0 += p0[r]; ls1 += p1[r]; }
            l += ls0 + ls1;
            const LAS unsigned char* va = Vs + q32 * AT_ROWB + hi * 16;
#pragma unroll
            for (int ph = 0; ph < 2; ++ph)
#pragma unroll
                for (int jj = 0; jj < 2; ++jj) {
                    u32x4 pw;
                    if (ph == 0) { pw.x = cvt_pk_bf16(p0[8 * jj + 0], p0[8 * jj + 1]); pw.y = cvt_pk_bf16(p0[8 * jj + 2], p0[8 * jj + 3]); pw.z = cvt_pk_bf16(p0[8 * jj + 4], p0[8 * jj + 5]); pw.w = cvt_pk_bf16(p0[8 * jj + 6], p0[8 * jj + 7]); }
                    else { pw.x = cvt_pk_bf16(p1[8 * jj + 0], p1[8 * jj + 1]); pw.y = cvt_pk_bf16(p1[8 * jj + 2], p1[8 * jj + 3]); pw.z = cvt_pk_bf16(p1[8 * jj + 4], p1[8 * jj + 5]); pw.w = cvt_pk_bf16(p1[8 * jj + 6], p1[8 * jj + 7]); }
                    const bf16x8 pb = __builtin_bit_cast(bf16x8, pw);
                    const bf16x8 v0 = *(const LAS bf16x8*)(va + 64 * ph + 32 * jj), v1 = *(const LAS bf16x8*)(va + 32 * AT_ROWB + 64 * ph + 32 * jj);
                    o0 = __builtin_amdgcn_mfma_f32_32x32x16_bf16(v0, pb, o0, 0, 0, 0);
                    o1 = __builtin_amdgcn_mfma_f32_32x32x16_bf16(v1, pb, o1, 0, 0, 0);
                }
        }
        if (j + 1 < nt) { const int nb = (cur ^ 1) * AT_SLOT;
            *(LAS u32x4*)(lds + nb + AT_K + sdst) = kreg; *(LAS u32x4*)(lds + nb + AT_V + sdst) = vreg;
            if (MODE == 0 && tid < 64) *(LAS u32x4*)(lds + nb + AT_K + tid * AT_ROWB + 128) = f3split(freg); }
        __syncthreads();
    }
    l += __shfl_xor(l, 32);
    const float inv = 1.0f / l;
    bf16_t* op = O + (tokbase + qloc) * DM + ocol + 4 * hi;
#pragma unroll
    for (int g = 0; g < 4; ++g) {
        u32x2 w0, w1;
        w0.x = cvt_pk_bf16(o0[4 * g] * inv, o0[4 * g + 1] * inv); w0.y = cvt_pk_bf16(o0[4 * g + 2] * inv, o0[4 * g + 3] * inv);
        w1.x = cvt_pk_bf16(o1[4 * g] * inv, o1[4 * g + 1] * inv); w1.y = cvt_pk_bf16(o1[4 * g + 2] * inv, o1[4 * g + 3] * inv);
        *(u32x2*)(op + 8 * g) = w0; *(u32x2*)(op + 32 + 8 * g) = w1;
    }
}

#define XB_TMO      128
#define XB_XCNT(j)  (256  + 64 * (j))
#define XB_XSUB(j)  (1280 + 64 * (j))
#define XB_XGEN(j)  (2304 + 64 * (j))
#define XB_TOP      3328
#define XB_TOPGEN   3392
#define XCD_BAR_WORDS 3456
#define XB_SPIN_CAP (1u << 18)

__device__ __forceinline__ unsigned xb_ld(unsigned* p)              { return __hip_atomic_load(p, __ATOMIC_RELAXED, __HIP_MEMORY_SCOPE_AGENT); }
__device__ __forceinline__ unsigned xb_add(unsigned* p, unsigned v) { return __hip_atomic_fetch_add(p, v, __ATOMIC_RELAXED, __HIP_MEMORY_SCOPE_AGENT); }
__device__ __forceinline__ unsigned xb_xcc_id() { return (unsigned)__builtin_amdgcn_s_getreg((3 << 11) | 20) & 0xFu; }
#define XB_SPIN(cond, bar) do { unsigned _sp = 0; while (cond) { __builtin_amdgcn_s_sleep(1); \
    if ((++_sp & 255u) == 0u) { if (xb_ld(&(bar)[XB_TMO])) break; if (_sp > XB_SPIN_CAP) { atomicAdd(&(bar)[XB_TMO], 1u); break; } } } } while (0)

struct XcdBarrier {
    unsigned* bar; unsigned x;
    volatile LAS unsigned* st;
};

__device__ __forceinline__ XcdBarrier xcd_barrier_post(unsigned* bar, volatile LAS unsigned* st) {
    XcdBarrier b; b.bar = bar; b.x = xb_xcc_id(); b.st = st;
    if (threadIdx.x == 0) (void)xb_add(&bar[XB_XCNT(b.x)], 1u);
    return b;
}
__device__ __forceinline__ void xcd_barrier_complete(unsigned* bar, unsigned x, unsigned& nloc, unsigned& nx) {
    const unsigned G = gridDim.x * gridDim.y * gridDim.z;
    unsigned sum, cnt, mine, sp = 0u;
    for (;;) {
        sum = 0u; cnt = 0u; mine = 0u;
#pragma unroll
        for (unsigned j = 0; j < 16; ++j) { const unsigned c = xb_ld(&bar[XB_XCNT(j)]); sum += c; cnt += (c > 0u) ? 1u : 0u; mine = (j == x) ? c : mine; }
        if (sum == G) break;
        __builtin_amdgcn_s_sleep(1);
        if ((++sp & 255u) == 0u) { if (xb_ld(&bar[XB_TMO])) break; if (sp > XB_SPIN_CAP) { atomicAdd(&bar[XB_TMO], 1u); break; } }
    }
    nloc = mine > 0u ? mine : 1u; nx = cnt > 0u ? cnt : 1u;
}

__device__ __forceinline__ void xcd_barrier(const XcdBarrier& b) {
    asm volatile("s_waitcnt vmcnt(0)" ::: "memory");
    __syncthreads();
    if (threadIdx.x == 0) {
        unsigned* bar = b.bar;
        __builtin_amdgcn_s_waitcnt(0);
        unsigned nloc = b.st[0], nx = b.st[1];
        if (nloc == 0u) { xcd_barrier_complete(bar, b.x, nloc, nx); b.st[0] = nloc; b.st[1] = nx; }
        const unsigned old = xb_add(&bar[XB_XSUB(b.x)], 1u);
        const unsigned gen = old / nloc;
        if (old + 1u == (gen + 1u) * nloc) {
            __builtin_amdgcn_fence(__ATOMIC_RELEASE, "agent");
            asm volatile("s_waitcnt vmcnt(0)" ::: "memory");
            const unsigned og = xb_add(&bar[XB_TOP], 1u);
            const unsigned tg = og / nx;
            if (og + 1u == (tg + 1u) * nx) xb_add(&bar[XB_TOPGEN], 1u);
            else XB_SPIN(xb_ld(&bar[XB_TOPGEN]) == tg, bar);
            __builtin_amdgcn_fence(__ATOMIC_ACQUIRE, "agent");
            xb_add(&bar[XB_XGEN(b.x)], 1u);
            asm volatile("s_waitcnt vmcnt(0)" ::: "memory");
        } else {
            XB_SPIN(xb_ld(&bar[XB_XGEN(b.x)]) == gen, bar);
            __builtin_amdgcn_fence(__ATOMIC_ACQUIRE, "agent");
            asm volatile("s_waitcnt vmcnt(0)" ::: "memory");
        }
    }
    __syncthreads();
}

__global__ void __launch_bounds__(512, 2) mega_fwd(Args a) {
    extern __shared__ __attribute__((aligned(16))) unsigned char lds_raw[];
    LAS unsigned char* lds = (LAS unsigned char*)lds_raw;
    cg::grid_group grid = cg::this_grid();
    if (threadIdx.x < 64) ((LAS unsigned*)(lds + 131072))[threadIdx.x] = 0u;
    if (blockIdx.x == 0) { for (int i = threadIdx.x; i < (int)(BAR_BYTES / 4); i += 512) ((unsigned*)(a.ws + WS_BAR))[i] = 0u; asm volatile("s_waitcnt vmcnt(0)" ::: "memory"); }
    __syncthreads();
    const int G = gridDim.x;
    const int vcu = (G % 8 == 0) ? ((int)blockIdx.x % 8) * (G / 8) + (int)blockIdx.x / 8 : (int)blockIdx.x;
    unsigned char* ws = a.ws;
    float* mod = (float*)(ws + WS_MOD); float* logf = (float*)(ws + WS_LOGF); float* F2 = (float*)(ws + WS_F2);
    bf16_t* H = (bf16_t*)(ws + WS_H); bf16_t* ACT = (bf16_t*)(ws + WS_ACT);
    const float* x = a.in[0]; float* out = a.out;
    constexpr bool AL = true, SP = true;

    grid.sync();
    const XcdBarrier xbar = xcd_barrier_post((unsigned*)(a.ws + WS_BAR), (volatile LAS unsigned*)(lds + 131072));
    for (int r_ = 0; r_ < R_P0; ++r_) prologue(a, lds, G);
    xcd_barrier(xbar);
    { const int gid = blockIdx.x * 512 + threadIdx.x;
      if (gid < 8192) { const int which = gid >> 12, bb = (gid >> 10) & 3, col = gid & 1023;
          ((float*)(ws + (which ? WS_GS3 : WS_GS2)))[bb * DM + col] = a.in[which ? 16 : 8][col] * (1.0f + mod[(size_t)bb * NMOD + (which ? 7 : 4) * DM + col]); }
      else if (gid < 16384) { const int i = gid - 8192; ((float*)(ws + WS_WF))[i] = a.in[9][(size_t)(i >> 3) * INC + 1536 + (i & 7)]; } }
    for (int r_ = 0; r_ < R_P1; ++r_) norm_phase<false>(x, a.in[4], mod + 0 * DM, mod + 1 * DM, H, nullptr, nullptr, nullptr, lds, G);
    { LAUNDER_TID(); convert_weights<0>(a, lds, (int)blockIdx.x * 8 + wave, G * 8, lane, wave); }
    xcd_barrier(xbar);
    if (PHMASK & 4) { pg8::Gemm g{H, (const bf16_t*)(ws + WS_WGU1), T_TOK, 2 * DFF, DM}; pg8::StaticOrderT<R_P2> S; S.init(T_TOK, 2 * DFF, G, (int)blockIdx.x);
      Epi<QSwiglu> E{{ACT}}; pg8::gemm_phase<Epi<QSwiglu>, pg8::StaticOrderT<R_P2>, AL, SP>(lds, g, S, E); }
    if (G == 256 && blockIdx.x >= 128) { LAUNDER_TID(); convert_weights<1>(a, lds, ((int)blockIdx.x - 128) * 8 + wave, 1024, lane, wave); }
    else if (G != 256) { LAUNDER_TID(); convert_weights<1>(a, lds, (int)blockIdx.x * 8 + wave, G * 8, lane, wave); }
    xcd_barrier(xbar);
    { pg8::Gemm g{ACT, (const bf16_t*)(ws + WS_WD1), T_TOK, DM, DFF}; pg8::StaticOrder S; S.init(T_TOK, DM, G, (int)blockIdx.x);
      EpiResNorm<0> E{x, out, mod + 2 * DM, 0.5f, H, (const float*)(ws + WS_GS2), mod + 3 * DM, nullptr, (float*)(ws + WS_XCH), (unsigned*)(ws + WS_CNT)};
      pg8::gemm_phase<EpiResNorm<0>, pg8::StaticOrder, false, SP>(lds, g, S, E); }
    xcd_barrier(xbar);
    fa_phase(H, (const float*)(ws + WS_WF), a.in[10], logf, lds, G);
    if (PHMASK & 64) { pg8::Gemm g{H, (const bf16_t*)(ws + WS_WIN), T_TOK, 5120, DM}; pg8::StaticOrderT<R_P5> S; S.init(T_TOK, 5120, G, (int)blockIdx.x);
      Epi<QWin> E{{(bf16_t*)(ws + WS_QA), (bf16_t*)(ws + WS_KA), (bf16_t*)(ws + WS_VTA), (bf16_t*)(ws + WS_QB), (bf16_t*)(ws + WS_KB), (bf16_t*)(ws + WS_VTB),
                   (_Float16*)(ws + WS_RATIO), (_Float16*)(ws + WS_GB), a.in[11]}};
      pg8::gemm_phase<Epi<QWin>, pg8::StaticOrderT<R_P5>, AL, SP>(lds, g, S, E); }
    xcd_barrier(xbar);
    if (PHMASK & 128) { bf16_t* ATT = (bf16_t*)(ws + WS_ATT);
      for (int i = vcu; i < 256 * ATT_REPS; i += G) {
          const int bh = (i & 255) >> 3, s = i & 7, b = bh >> 3, h = bh & 7;
          const LAS float* FL = (const LAS float*)(lds + AT_FL);
          scan_block(logf, b, h, (LAS float*)(lds + AT_FL), (LAS float*)(lds + AT_WT));
          attn_unit<0>(lds, (const bf16_t*)(ws + WS_QA), (const bf16_t*)(ws + WS_KA), (const bf16_t*)(ws + WS_VTA), FL, nullptr, ATT, h * 64, b, h, s);
          attn_unit<0>(lds, (const bf16_t*)(ws + WS_QA), (const bf16_t*)(ws + WS_KA), (const bf16_t*)(ws + WS_VTA), FL, nullptr, ATT, h * 64, b, h, 15 - s);
          attn_unit<1>(lds, (const bf16_t*)(ws + WS_QB), (const bf16_t*)(ws + WS_KB), (const bf16_t*)(ws + WS_VTB), FL, a.in[12] + h * 257, ATT, 512 + h * 64, b, h, 2 * s);
          attn_unit<1>(lds, (const bf16_t*)(ws + WS_QB), (const bf16_t*)(ws + WS_KB), (const bf16_t*)(ws + WS_VTB), FL, a.in[12] + h * 257, ATT, 512 + h * 64, b, h, 2 * s + 1);
      } }
    xcd_barrier(xbar);
    { pg8::Gemm g{(const bf16_t*)(ws + WS_ATT), (const bf16_t*)(ws + WS_WAB), T_TOK, DM, DM}; pg8::StaticOrderT<R_P7> S; S.init(T_TOK, DM, G, (int)blockIdx.x);
      Epi<QGate> E{{(const _Float16*)(ws + WS_RATIO), (const _Float16*)(ws + WS_GB), (bf16_t*)(ws + WS_M)}};
      pg8::gemm_phase<Epi<QGate>, pg8::StaticOrderT<R_P7>, AL, SP, 8>(lds, g, S, E); }
    xcd_barrier(xbar);
    { pg8::Gemm g{(const bf16_t*)(ws + WS_M), (const bf16_t*)(ws + WS_WOUT), T_TOK, DM, DM}; pg8::StaticOrder S; S.init(T_TOK, DM, G, (int)blockIdx.x);
      EpiResNorm<0> E{out, out, mod + 5 * DM, 1.0f, H, (const float*)(ws + WS_GS3), mod + 6 * DM, nullptr, (float*)(ws + WS_XCH) + 65536, (unsigned*)(ws + WS_CNT) + 1024};
      pg8::gemm_phase<EpiResNorm<0>, pg8::StaticOrder, false, SP>(lds, g, S, E); }
    xcd_barrier(xbar);
    if (PHMASK & 2048) { pg8::Gemm g{H, (const bf16_t*)(ws + WS_WGU2), T_TOK, 2 * DFF, DM}; pg8::StaticOrder S; S.init(T_TOK, 2 * DFF, G, (int)blockIdx.x);
      Epi<QSwiglu> E{{ACT}}; pg8::gemm_phase<Epi<QSwiglu>, pg8::StaticOrder, AL, SP>(lds, g, S, E); }
    if (G == 256 && blockIdx.x >= 128) { LAUNDER_TID(); convert_weights<2>(a, lds, ((int)blockIdx.x - 128) * 8 + wave, 1024, lane, wave); }
    else if (G != 256) { LAUNDER_TID(); convert_weights<2>(a, lds, (int)blockIdx.x * 8 + wave, G * 8, lane, wave); }
    xcd_barrier(xbar);
    {
      pg8::Gemm g{ACT, (const bf16_t*)(ws + WS_WD2), T_TOK, DM, DFF}; pg8::StaticOrder S; S.init(T_TOK, DM, G, (int)blockIdx.x);
      EpiResNorm<1> E{out, out, mod + 8 * DM, 0.5f, nullptr, nullptr, nullptr, a.in[20], (float*)(ws + WS_XCH) + 2 * 65536, (unsigned*)(ws + WS_CNT) + 2 * 1024};
      pg8::gemm_phase<EpiResNorm<1>, pg8::StaticOrder, false, SP>(lds, g, S, E); }
}

extern "C" void kernel_launch(void* const* d_in, const int* in_sizes, int n_in, void* d_out, int out_size, void* d_ws, size_t ws_size, hipStream_t stream) {
    static int grid = 0;
    if (grid == 0) {
        if (n_in != 21 || out_size != T_TOK * DM || ws_size < WS_END) { fprintf(stderr, "kernel_launch: unexpected shapes (n_in %d out %d ws %zu)\n", n_in, out_size, ws_size); grid = -1; return; }
        int dev = 0, cus = 0, per_cu = 0;
        hipGetDevice(&dev); hipDeviceGetAttribute(&cus, hipDeviceAttributeMultiprocessorCount, dev);
        hipFuncSetAttribute((const void*)mega_fwd, hipFuncAttributeMaxDynamicSharedMemorySize, LDS_BYTES);
        hipOccupancyMaxActiveBlocksPerMultiprocessor(&per_cu, (const void*)mega_fwd, 512, LDS_BYTES);
        if (per_cu < 1) per_cu = 1;
        (void)hipGetLastError();
        grid = cus * per_cu;
    }
    if (grid < 0) return;
    Args a{};
    for (int i = 0; i < 21; ++i) a.in[i] = (const float*)d_in[i];
    a.out = (float*)d_out; a.ws = (unsigned char*)d_ws;
    void* args[] = {&a};
    hipError_t e = hipLaunchCooperativeKernel((const void*)mega_fwd, dim3(grid), dim3(512), args, LDS_BYTES, stream);
    if (e != hipSuccess) fprintf(stderr, "cooperative launch failed: %s (grid %d)\n", hipGetErrorString(e), grid);
}
```

```cpp
#include <hip/hip_runtime.h>
#include <hip/hip_cooperative_groups.h>
#include <cstdio>
#include <cstdint>
namespace pg8 {
#define PG8_LAS __attribute__((address_space(3)))
typedef unsigned short bf16_t;
typedef short bf16x8 __attribute__((ext_vector_type(8)));
typedef float f32x4 __attribute__((ext_vector_type(4)));
typedef unsigned u32x4 __attribute__((ext_vector_type(4)));
constexpr int BM = 256, BK = 64, HALF = 128, HTB = HALF * BK * 2  , STAGE_BYTES = 8 * HTB, NXCD = 8, WGM = 2;

__host__ __device__ __forceinline__ int lds_byte(int r, int c) { const int st = (r >> 4) * 2 + (c >> 5), rr = r & 15, cc = c & 31, ob = rr * 64 + cc * 2; return st * 1024 + (ob ^ (((ob >> 9) & 1) << 5)); }
__host__ __device__ __forceinline__ void stage_rc(int b, int& R, int& C) { const int st = b / 1024, sb = b % 1024, swz = sb ^ (((sb >> 9) & 1) << 5); R = (st >> 1) * 16 + swz / 64; C = (st & 1) * 32 + (swz % 64) / 2; }
__host__ __device__ __forceinline__ int perm32(int rho) { const int n = rho >> 4, i = rho & 15; return 8 * (i >> 2) + 4 * n + (i & 3); }

struct Unit { int pm, pn; };
struct Gemm { const bf16_t* A; const bf16_t* Bt; int M, N, K; };

template <int REPS = 1> struct StaticOrderT {
    int nM, nN, nwg, G, c;
    __host__ __device__ void init(int M, int N, int G_, int c_) { nM = M / BM; nN = N / BM; nwg = nM * nN; G = G_; c = c_; }
    __host__ __device__ bool next(int i, Unit& u) const {
        const long L = (long)i * G + c; if (L >= (long)nwg * REPS) return false;
        int wgid = (REPS > 1) ? (int)(L % nwg) : (int)L; { const int q = nwg / NXCD, r = nwg % NXCD, xcd = wgid % NXCD, off = wgid / NXCD; wgid = (xcd < r ? xcd * (q + 1) : r * (q + 1) + (xcd - r) * q) + off; }
        const int nig = WGM * nN, gid = wgid / nig, fm = gid * WGM, gsz = (nM - fm) < WGM ? (nM - fm) : WGM;
        u.pm = fm + ((wgid % nig) % gsz); u.pn = (wgid % nig) / gsz; return true;
    }
    __device__ __forceinline__ void a_ready(const Unit&) const {}
    __device__ __forceinline__ void done(const Unit&) const {}
};
typedef StaticOrderT<1> StaticOrder;

__device__ __forceinline__ unsigned cvt_pk_bf16(float lo, float hi) { unsigned r; asm volatile("v_cvt_pk_bf16_f32 %0, %1, %2" : "=v"(r) : "v"(lo), "v"(hi)); return r; }
template <class Epi, class Sched, bool ALIGN_EPI = false, bool SP2 = false, int MIDT = 0>
__device__ __forceinline__ void gemm_phase(PG8_LAS unsigned char* lds, const Gemm g, const Sched& S, const Epi& E) {
    int tid_ = threadIdx.x; asm volatile("" : "+v"(tid_));
    const int tid = tid_, wid = __builtin_amdgcn_readfirstlane(tid >> 6), lane = tid & 63, wr = wid >> 2, wc = wid & 3, fr = lane & 15, fq = lane >> 4;
    const int K = g.K, nt = K / BK;
    unsigned voffA[2], voffB[2];
#pragma unroll
    for (int i = 0; i < 2; ++i) { int R, C; stage_rc(tid * 16 + i * 8192, R, C); const int Rb = Epi::PERM ? ((R & ~31) + perm32(R & 31)) : R;
        voffA[i] = (unsigned)(R * K + C) * 2u; voffB[i] = (unsigned)(Rb * K + C) * 2u; }
    const size_t kstep = (size_t)(BK * 2);
    const size_t hstep = (size_t)HALF * K * 2;
    const size_t tstep = 2 * hstep;
    const unsigned ldsw = (unsigned)wid * 1024u;
    const int aoff = lds_byte(wr * 64 + fr, fq * 8), boff = lds_byte(wc * 32 + fr, fq * 8);
#define PG8_SA(b, h) (((b) * 2 + (h)) * HTB)
#define PG8_SB(b, h) ((4 + (b) * 2 + (h)) * HTB)
#define PG8_STAGE(bufoff, gbase, voff) do { _Pragma("unroll") for (int _i = 0; _i < 2; ++_i) \
        __builtin_amdgcn_global_load_lds((const unsigned*)((const char*)(gbase) + (voff)[_i]), (PG8_LAS unsigned*)(lds + (bufoff) + ldsw + _i * 8192), 16, 0, 0); } while (0)
#define PG8_LDA(dst, b, h) do { _Pragma("unroll") for (int m = 0; m < 4; ++m) _Pragma("unroll") for (int k = 0; k < 2; ++k) dst[m][k] = *(const PG8_LAS bf16x8*)(lds + PG8_SA(b, h) + aoff + m * 2048 + k * 1024); } while (0)
#define PG8_LDB(dst, b, h) do { _Pragma("unroll") for (int n = 0; n < 2; ++n) _Pragma("unroll") for (int k = 0; k < 2; ++k) dst[n][k] = *(const PG8_LAS bf16x8*)(lds + PG8_SB(b, h) + boff + n * 2048 + k * 1024); } while (0)
#define PG8_MMA(ai, bj, At, Bt) do { __builtin_amdgcn_s_setprio(1); _Pragma("unroll") for (int m = 0; m < 4; ++m) _Pragma("unroll") for (int n = 0; n < 2; ++n) _Pragma("unroll") for (int k = 0; k < 2; ++k) \
        acc[ai][bj][m][n] = __builtin_amdgcn_mfma_f32_16x16x32_bf16(Bt[n][k], At[m][k], acc[ai][bj][m][n], 0, 0, 0); __builtin_amdgcn_s_setprio(0); } while (0)
#define PG8_WAIT_V(n) asm volatile("s_waitcnt vmcnt(" #n ")" ::: "memory")
#define PG8_WAIT_L(n) asm volatile("s_waitcnt lgkmcnt(" #n ")" ::: "memory")
#define PG8_BAR __builtin_amdgcn_s_barrier()
#define PG8_SCHED __builtin_amdgcn_sched_barrier(0)
    Unit cur, nxt; int ui = 0;
    if (!S.next(0, cur)) return;
    f32x4 acc[2][2][4][2];
#pragma unroll
    for (int a = 0; a < 2; ++a)
#pragma unroll
        for (int b = 0; b < 2; ++b)
#pragma unroll
            for (int m = 0; m < 4; ++m)
#pragma unroll
                for (int n = 0; n < 2; ++n) acc[a][b][m][n] = (f32x4){0.f, 0.f, 0.f, 0.f};
    bf16x8 At[4][2], B0[2][2], B1[2][2];
    const char* cA = (const char*)g.A + (size_t)cur.pm * tstep; const char* cB = (const char*)g.Bt + (size_t)cur.pn * tstep;
    S.a_ready(cur);
    if constexpr (SP2) {
        PG8_STAGE(PG8_SB(0, 0), cB, voffB); PG8_STAGE(PG8_SB(0, 1), cB + hstep, voffB); PG8_STAGE(PG8_SA(0, 0), cA, voffA); PG8_STAGE(PG8_SA(0, 1), cA + hstep, voffA);
        if (wr == 1) PG8_BAR;
        PG8_WAIT_V(2); PG8_BAR;
        PG8_STAGE(PG8_SB(1, 0), cB + kstep, voffB); PG8_STAGE(PG8_SA(1, 0), cA + kstep, voffA); PG8_STAGE(PG8_SB(1, 1), cB + hstep + kstep, voffB);
        PG8_WAIT_V(6); PG8_BAR;
    } else {
        PG8_STAGE(PG8_SB(0, 0), cB, voffB); PG8_STAGE(PG8_SA(0, 0), cA, voffA); PG8_STAGE(PG8_SB(0, 1), cB + hstep, voffB); PG8_STAGE(PG8_SA(0, 1), cA + hstep, voffA);
        if (wr == 1) PG8_BAR;
        PG8_WAIT_V(4); PG8_BAR;
        PG8_STAGE(PG8_SB(1, 0), cB + kstep, voffB); PG8_STAGE(PG8_SA(1, 0), cA + kstep, voffA); PG8_STAGE(PG8_SB(1, 1), cB + hstep + kstep, voffB);
        PG8_WAIT_V(6); PG8_BAR;
    }
    for (;;) {
        const bool has_next = S.next(ui + 1, nxt);
        const char* nA = has_next ? (const char*)g.A + (size_t)nxt.pm * tstep : cA; const char* nB = has_next ? (const char*)g.Bt + (size_t)nxt.pn * tstep : cB;
        for (int t = 0; t < nt; t += 2) {
            const bool last = (t == nt - 2);
            if constexpr (MIDT > 0) { if (t == MIDT) E.mid(acc, cur, wr, wc, fr, fq); }
            const char* a1 = cA + (size_t)(t + 1) * kstep;
            const char* a2 = last ? nA : cA + (size_t)(t + 2) * kstep; const char* b2 = last ? nB : cB + (size_t)(t + 2) * kstep;
            const char* a3 = a2 + kstep; const char* b3 = b2 + kstep;
            if (last && has_next) S.a_ready(nxt);
            if constexpr (SP2) {
            PG8_LDB(B0, 0, 0); PG8_LDB(B1, 0, 1); PG8_SCHED; PG8_LDA(At, 0, 0); PG8_STAGE(PG8_SA(1, 1), a1 + hstep, voffA);
            PG8_WAIT_V(8); PG8_WAIT_L(0); PG8_BAR; PG8_MMA(0, 0, At, B0); PG8_MMA(0, 1, At, B1); PG8_BAR; PG8_SCHED;
            PG8_LDA(At, 0, 1); PG8_STAGE(PG8_SB(0, 0), b2, voffB); PG8_STAGE(PG8_SB(0, 1), b2 + hstep, voffB); PG8_STAGE(PG8_SA(0, 0), a2, voffA);
            PG8_WAIT_V(8); PG8_WAIT_L(0); PG8_BAR; PG8_MMA(1, 0, At, B0); PG8_MMA(1, 1, At, B1); PG8_BAR; PG8_SCHED;
            PG8_LDB(B0, 1, 0); PG8_LDB(B1, 1, 1); PG8_SCHED; PG8_LDA(At, 1, 0); PG8_STAGE(PG8_SA(0, 1), a2 + hstep, voffA);
            PG8_WAIT_V(8); PG8_WAIT_L(0); PG8_BAR; PG8_MMA(0, 0, At, B0); PG8_MMA(0, 1, At, B1); PG8_BAR; PG8_SCHED;
            PG8_LDA(At, 1, 1); PG8_STAGE(PG8_SB(1, 0), b3, voffB); PG8_STAGE(PG8_SB(1, 1), b3 + hstep, voffB); PG8_STAGE(PG8_SA(1, 0), a3, voffA);
            PG8_WAIT_V(8); PG8_WAIT_L(0); PG8_BAR; PG8_MMA(1, 0, At, B0); PG8_MMA(1, 1, At, B1); PG8_BAR; PG8_SCHED;
            } else {
            PG8_LDB(B0, 0, 0); PG8_SCHED; PG8_LDA(At, 0, 0); PG8_STAGE(PG8_SA(1, 1), a1 + hstep, voffA);
            PG8_WAIT_L(8); PG8_BAR; PG8_WAIT_L(0); PG8_MMA(0, 0, At, B0); PG8_BAR; PG8_SCHED;
            PG8_LDB(B1, 0, 1); PG8_STAGE(PG8_SB(0, 0), b2, voffB);
            PG8_BAR; PG8_WAIT_L(0); PG8_MMA(0, 1, At, B1); PG8_BAR;
            PG8_LDA(At, 0, 1); PG8_STAGE(PG8_SA(0, 0), a2, voffA);
            PG8_BAR; PG8_WAIT_L(0); PG8_MMA(1, 0, At, B0); PG8_BAR; PG8_SCHED;
            PG8_STAGE(PG8_SB(0, 1), b2 + hstep, voffB);
            PG8_WAIT_V(6); PG8_BAR; PG8_MMA(1, 1, At, B1); PG8_BAR;
            PG8_LDB(B0, 1, 0); PG8_SCHED; PG8_LDA(At, 1, 0); PG8_STAGE(PG8_SA(0, 1), a2 + hstep, voffA);
            PG8_WAIT_L(8); PG8_BAR; PG8_WAIT_L(0); PG8_MMA(0, 0, At, B0); PG8_BAR; PG8_SCHED;
            PG8_LDB(B1, 1, 1); PG8_STAGE(PG8_SB(1, 0), b3, voffB);
            PG8_BAR; PG8_WAIT_L(0); PG8_MMA(0, 1, At, B1); PG8_BAR;
            PG8_LDA(At, 1, 1); PG8_STAGE(PG8_SA(1, 0), a3, voffA);
            PG8_BAR; PG8_WAIT_L(0); PG8_MMA(1, 0, At, B0); PG8_BAR; PG8_SCHED;
            PG8_STAGE(PG8_SB(1, 1), b3 + hstep, voffB);
            PG8_WAIT_V(6); PG8_BAR; PG8_MMA(1, 1, At, B1); PG8_BAR;
            }
        }
        if constexpr (ALIGN_EPI) { if (wr == 0) PG8_BAR; }
        if constexpr (!Epi::AFTER_DRAIN) { E(acc, cur, wr, wc, fr, fq); S.done(cur); }
        if (!has_next) break;
#pragma unroll
        for (int a = 0; a < 2; ++a)
#pragma unroll
            for (int b = 0; b < 2; ++b)
#pragma unroll
                for (int m = 0; m < 4; ++m)
#pragma unroll
                    for (int n = 0; n < 2; ++n) acc[a][b][m][n] = (f32x4){0.f, 0.f, 0.f, 0.f};
        cur = nxt; cA = nA; cB = nB; ++ui;
        if constexpr (ALIGN_EPI) { if (wr == 1) PG8_BAR; }
    }
    PG8_WAIT_V(0);
    if constexpr (!ALIGN_EPI) { if (wr == 0) PG8_BAR; }
    PG8_BAR;
    if constexpr (Epi::AFTER_DRAIN) { E.fused(acc, cur, wr, wc, fr, fq, lds, wid, lane); S.done(cur); }
#undef PG8_SA
#undef PG8_SB
#undef PG8_STAGE
#undef PG8_LDA
#undef PG8_LDB
#undef PG8_MMA
#undef PG8_WAIT_V
#undef PG8_WAIT_L
#undef PG8_BAR
#undef PG8_SCHED
}
}
namespace cg = cooperative_groups;
#define LAS __attribute__((address_space(3)))
using pg8::bf16_t; using pg8::bf16x8; using pg8::f32x4; using pg8::u32x4; using pg8::cvt_pk_bf16;
typedef float f32x16 __attribute__((ext_vector_type(16)));
typedef unsigned u32x2 __attribute__((ext_vector_type(2)));
typedef _Float16 h16x8 __attribute__((ext_vector_type(8)));

constexpr int T_TOK = 16384, DM = 1024, SEQ = 4096, DFF = 2816, NMOD = 9216, INC = 5128;
constexpr float LOG2E = 1.4426950408889634f, C2 = 0.125f * 1.4426950408889634f, EPS = 1e-6f;
constexpr size_t MiB = 1u << 20;
constexpr size_t WS_GS2 = 160 * 1024, WS_GS3 = 176 * 1024, WS_WF = 192 * 1024;
constexpr size_t WS_MOD = 0, WS_LOGF = 256 * 1024, WS_F2 = 768 * 1024, WS_BAR = 1536 * 1024, BAR_BYTES = 32768, WS_CNT = WS_BAR + 16384, WS_XCH = 768 * 1024;
constexpr size_t SZ_WGU = (size_t)5632 * 1024 * 2, SZ_WD = (size_t)1024 * 2816 * 2;
constexpr size_t WS_WGU1 = 2 * MiB, WS_WD1 = WS_WGU1 + SZ_WGU, WS_WGU2 = WS_WD1 + SZ_WD, WS_WD2 = WS_WGU2 + SZ_WGU, WS_WIN = WS_WD2 + SZ_WD;
constexpr size_t WS_WAB = WS_WIN + 10 * MiB, WS_WOUT = WS_WAB + 2 * MiB, WS_H = WS_WOUT + 2 * MiB;
static_assert(WS_H == 49 * MiB, "ws map");
constexpr size_t WS_ACT = 81 * MiB;
constexpr size_t WS_QA = 81 * MiB, WS_KA = 97 * MiB, WS_VTA = 113 * MiB, WS_QB = 129 * MiB, WS_KB = 145 * MiB, WS_VTB = 161 * MiB, WS_RATIO = 177 * MiB, WS_GB = 209 * MiB, WS_END = 241 * MiB;
constexpr size_t WS_ATT = WS_H, WS_M = WS_QA, WS_TMP = WS_VTA;
constexpr int LDS_BYTES = 131072 + 1024;
#ifndef PHMASK
#define PHMASK 0xFFFF
#endif
#ifndef ATT_REPS
#define ATT_REPS 1
#endif
#ifndef R_P2
#define R_P2 1
#endif
#ifndef R_P3
#define R_P3 1
#endif
#ifndef R_P5
#define R_P5 1
#endif
#ifndef R_P7
#define R_P7 1
#endif
#ifndef R_P0
#define R_P0 1
#endif
#ifndef R_P1
#define R_P1 1
#endif

#define LAUNDER_TID() int tid = threadIdx.x; asm volatile("" : "+v"(tid)); const int lane = tid & 63, wave = __builtin_amdgcn_readfirstlane(tid >> 6); (void)lane; (void)wave
__device__ __forceinline__ float wave_sum(float v) {
#pragma unroll
    for (int o = 1; o < 64; o <<= 1) v += __shfl_xor(v, o);
    return v;
}
__device__ __forceinline__ float silu_f(float x) { return x * __builtin_amdgcn_rcpf(1.0f + __builtin_amdgcn_exp2f(-x * LOG2E)); }

template <class Q> struct Epi {
    static constexpr bool PERM = true, AFTER_DRAIN = false; Q q;
    __device__ __forceinline__ void operator()(f32x4 (&acc)[2][2][4][2], const pg8::Unit& u, int wr, int wc, int fr, int fq) const {
        const int row0 = u.pm * 256 + wr * 64 + fr, c0 = wc * 32 + 8 * fq;
#pragma unroll
        for (int ai = 0; ai < 2; ++ai)
#pragma unroll
            for (int m = 0; m < 4; ++m) q.oct(row0 + ai * 128 + m * 16, u.pn, c0, acc[ai][0][m][0], acc[ai][0][m][1], acc[ai][1][m][0], acc[ai][1][m][1]);
    }
    __device__ __forceinline__ void mid(f32x4 (&acc)[2][2][4][2], const pg8::Unit& u, int wr, int wc, int fr, int fq) const {
        const int row0 = u.pm * 256 + wr * 64 + fr, c0 = wc * 32 + 8 * fq;
#pragma unroll
        for (int ai = 0; ai < 2; ++ai)
#pragma unroll
            for (int m = 0; m < 4; ++m) { q.mid(row0 + ai * 128 + m * 16, u.pn, c0, acc[ai][0][m][0], acc[ai][0][m][1], acc[ai][1][m][0], acc[ai][1][m][1]); asm volatile("" ::: "memory"); }
    }
};
__device__ __forceinline__ u32x4 pack8(f32x4 lo, f32x4 hi) { u32x4 w; w.x = cvt_pk_bf16(lo[0], lo[1]); w.y = cvt_pk_bf16(lo[2], lo[3]); w.z = cvt_pk_bf16(hi[0], hi[1]); w.w = cvt_pk_bf16(hi[2], hi[3]); return w; }

struct QSwiglu {
    bf16_t* O;
    __device__ __forceinline__ void oct(int row, int pn, int c0, f32x4 a0, f32x4 a1, f32x4 b0, f32x4 b1) const {
        f32x4 lo, hi;
#pragma unroll
        for (int i = 0; i < 4; ++i) { lo[i] = silu_f(a0[i]) * b0[i]; hi[i] = silu_f(a1[i]) * b1[i]; }
        *(u32x4*)(O + (size_t)row * DFF + pn * 128 + c0) = pack8(lo, hi);
    }
    __device__ __forceinline__ void mid(int, int, int, f32x4&, f32x4&, f32x4&, f32x4&) const {}
};
struct QResid {
    const float* base; float* out; const float* g; float coef;
    __device__ __forceinline__ void oct(int row, int pn, int c0, f32x4 a0, f32x4 a1, f32x4 b0, f32x4 b1) const {
        const int b = row >> 12; const float* gp = g + (size_t)b * NMOD + pn * 256 + c0; const size_t off = (size_t)row * DM + pn * 256 + c0;
        const f32x4 g0 = *(const f32x4*)gp, g1 = *(const f32x4*)(gp + 4), g2 = *(const f32x4*)(gp + 128), g3 = *(const f32x4*)(gp + 132);
        const f32x4 x0 = *(const f32x4*)(base + off), x1 = *(const f32x4*)(base + off + 4), x2 = *(const f32x4*)(base + off + 128), x3 = *(const f32x4*)(base + off + 132);
        *(f32x4*)(out + off) = x0 + coef * g0 * a0; *(f32x4*)(out + off + 4) = x1 + coef * g1 * a1;
        *(f32x4*)(out + off + 128) = x2 + coef * g2 * b0; *(f32x4*)(out + off + 132) = x3 + coef * g3 * b1;
    }
    __device__ __forceinline__ void mid(int, int, int, f32x4&, f32x4&, f32x4&, f32x4&) const {}
};
struct QWin {
    bf16_t *QA, *KA, *VTA, *QB, *KB, *VTB; _Float16 *RATIO, *GB; const float* bgate;
    __device__ __forceinline__ void oct(int row, int pn, int c0, f32x4 a0, f32x4 a1, f32x4 b0, f32x4 b1) const {
        if (pn < 12) {
            const int kind = pn >> 1, colb = 256 * (pn & 1) + c0;
            if (kind == 2 || kind == 5) {
                bf16_t* VT = (kind == 2) ? VTA : VTB; const int b = row >> 12, s = row & 4095;
#pragma unroll
                for (int i = 0; i < 8; ++i) {
                    const float va = i < 4 ? a0[i & 3] : a1[i & 3], vb = i < 4 ? b0[i & 3] : b1[i & 3];
                    const int ca = colb + i, cb = colb + 128 + i;
                    VT[((size_t)(b * 8 + (ca >> 6)) * 64 + (ca & 63)) * SEQ + s] = (bf16_t)(cvt_pk_bf16(va, 0.f) & 0xffffu);
                    VT[((size_t)(b * 8 + (cb >> 6)) * 64 + (cb & 63)) * SEQ + s] = (bf16_t)(cvt_pk_bf16(vb, 0.f) & 0xffffu);
                }
            } else {
                bf16_t* P = (kind == 0) ? QA : (kind == 1) ? KA : (kind == 3) ? QB : KB;
                const float sc = (kind == 0 || kind == 3) ? C2 : 1.0f;
                *(u32x4*)(P + (size_t)row * 512 + colb) = pack8(a0 * sc, a1 * sc);
                *(u32x4*)(P + (size_t)row * 512 + colb + 128) = pack8(b0 * sc, b1 * sc);
            }
        } else {
            const int col = 128 * (pn - 12) + c0;
            h16x8 r, gbv;
#pragma unroll
            for (int i = 0; i < 8; ++i) {
                const float za = (i < 4 ? a0[i & 3] : a1[i & 3]) + bgate[col + i], zb = (i < 4 ? b0[i & 3] : b1[i & 3]) + bgate[DM + col + i];
                const float ea = __builtin_amdgcn_exp2f(-za * LOG2E), eb = __builtin_amdgcn_exp2f(-zb * LOG2E);
                r[i] = (_Float16)((1.0f + eb) * __builtin_amdgcn_rcpf(1.0f + ea));
                gbv[i] = (_Float16)__builtin_amdgcn_rcpf(1.0f + eb);
            }
            *(h16x8*)(RATIO + (size_t)row * DM + col) = r; *(h16x8*)(GB + (size_t)row * DM + col) = gbv;
        }
    }
    __device__ __forceinline__ void mid(int, int, int, f32x4&, f32x4&, f32x4&, f32x4&) const {}
};
struct QGate1 {
    const _Float16* RATIO; float* TMP;
    __device__ __forceinline__ void oct(int row, int pn, int c0, f32x4 a0, f32x4 a1, f32x4 b0, f32x4 b1) const {
        const _Float16* rp = RATIO + (size_t)row * DM + pn * 256 + c0; const h16x8 r0 = *(const h16x8*)rp, r1 = *(const h16x8*)(rp + 128);
#pragma unroll
        for (int i = 0; i < 4; ++i) { a0[i] *= (float)r0[i]; a1[i] *= (float)r0[4 + i]; b0[i] *= (float)r1[i]; b1[i] *= (float)r1[4 + i]; }
        float* tp = TMP + (size_t)row * DM + pn * 256 + c0;
        *(f32x4*)tp = a0; *(f32x4*)(tp + 4) = a1; *(f32x4*)(tp + 128) = b0; *(f32x4*)(tp + 132) = b1;
    }
    __device__ __forceinline__ void mid(int, int, int, f32x4&, f32x4&, f32x4&, f32x4&) const {}
};
struct QGate2 {
    const _Float16* GB; const float* TMP; bf16_t* M;
    __device__ __forceinline__ void oct(int row, int pn, int c0, f32x4 a0, f32x4 a1, f32x4 b0, f32x4 b1) const {
        const _Float16* rp = GB + (size_t)row * DM + pn * 256 + c0; const h16x8 r0 = *(const h16x8*)rp, r1 = *(const h16x8*)(rp + 128);
        const float* tp = TMP + (size_t)row * DM + pn * 256 + c0;
        a0 += *(const f32x4*)tp; a1 += *(const f32x4*)(tp + 4); b0 += *(const f32x4*)(tp + 128); b1 += *(const f32x4*)(tp + 132);
#pragma unroll
        for (int i = 0; i < 4; ++i) { a0[i] *= (float)r0[i]; a1[i] *= (float)r0[4 + i]; b0[i] *= (float)r1[i]; b1[i] *= (float)r1[4 + i]; }
        bf16_t* mp = M + (size_t)row * DM + pn * 256 + c0;
        *(u32x4*)mp = pack8(a0, a1); *(u32x4*)(mp + 128) = pack8(b0, b1);
    }
    __device__ __forceinline__ void mid(int, int, int, f32x4&, f32x4&, f32x4&, f32x4&) const {}
};

struct QGate {
    const _Float16* RATIO; const _Float16* GB; bf16_t* M;
    __device__ __forceinline__ void mid(int row, int pn, int c0, f32x4& a0, f32x4& a1, f32x4& b0, f32x4& b1) const {
        const unsigned off = ((unsigned)row * DM + (unsigned)(pn * 256 + c0)) * 2u;
        const h16x8 r0 = *(const h16x8*)((const char*)RATIO + off), r1 = *(const h16x8*)((const char*)RATIO + off + 256);
#pragma unroll
        for (int i = 0; i < 4; ++i) { a0[i] *= (float)r0[i]; a1[i] *= (float)r0[4 + i]; b0[i] *= (float)r1[i]; b1[i] *= (float)r1[4 + i]; }
    }
    __device__ __forceinline__ void oct(int row, int pn, int c0, f32x4 a0, f32x4 a1, f32x4 b0, f32x4 b1) const {
        const _Float16* rp = GB + (size_t)row * DM + pn * 256 + c0; const h16x8 r0 = *(const h16x8*)rp, r1 = *(const h16x8*)(rp + 128);
#pragma unroll
        for (int i = 0; i < 4; ++i) { a0[i] *= (float)r0[i]; a1[i] *= (float)r0[4 + i]; b0[i] *= (float)r1[i]; b1[i] *= (float)r1[4 + i]; }
        bf16_t* mp = M + (size_t)row * DM + pn * 256 + c0;
        *(u32x4*)mp = pack8(a0, a1); *(u32x4*)(mp + 128) = pack8(b0, b1);
    }
};

template <int MODE> struct EpiResNorm {
    static constexpr bool PERM = true, AFTER_DRAIN = true;
    const float* base; float* xout; const float* g; float coef;
    bf16_t* H; const float* gs; const float* sh; const float* fin;
    float* xch; unsigned* cnt;
    __device__ __forceinline__ void fused(f32x4 (&acc)[2][2][4][2], const pg8::Unit& u, int wr, int wc, int fr, int fq, LAS unsigned char* lds, int wid, int lane) const {
        const int tid = wid * 64 + lane, c0 = wc * 32 + 8 * fq, b = (u.pm * 256) >> 12, colA = u.pn * 256 + c0, colB = colA + 128;
        LAS float* P = (LAS float*)lds; LAS float* S = (LAS float*)(lds + 4096);
        {
            const float* gp = g + (size_t)b * NMOD;
            const f32x4 g0 = *(const f32x4*)(gp + colA) * coef, g1 = *(const f32x4*)(gp + colA + 4) * coef, g2 = *(const f32x4*)(gp + colB) * coef, g3 = *(const f32x4*)(gp + colB + 4) * coef;
#pragma unroll
            for (int ai = 0; ai < 2; ++ai)
#pragma unroll
                for (int m = 0; m < 4; ++m) {
                    const int r = ai * 128 + wr * 64 + m * 16 + fr; const size_t off = (size_t)(u.pm * 256 + r) * DM;
                    const f32x4 x0 = *(const f32x4*)(base + off + colA) + g0 * acc[ai][0][m][0], x1 = *(const f32x4*)(base + off + colA + 4) + g1 * acc[ai][0][m][1];
                    const f32x4 x2 = *(const f32x4*)(base + off + colB) + g2 * acc[ai][1][m][0], x3 = *(const f32x4*)(base + off + colB + 4) + g3 * acc[ai][1][m][1];
                    acc[ai][0][m][0] = x0; acc[ai][0][m][1] = x1; acc[ai][1][m][0] = x2; acc[ai][1][m][1] = x3;
                    if (MODE == 0) { *(f32x4*)(xout + off + colA) = x0; *(f32x4*)(xout + off + colA + 4) = x1; *(f32x4*)(xout + off + colB) = x2; *(f32x4*)(xout + off + colB + 4) = x3; }
                    float ss = ((x0[0] * x0[0] + x0[1] * x0[1]) + (x0[2] * x0[2] + x0[3] * x0[3])) + ((x1[0] * x1[0] + x1[1] * x1[1]) + (x1[2] * x1[2] + x1[3] * x1[3]))
                             + ((x2[0] * x2[0] + x2[1] * x2[1]) + (x2[2] * x2[2] + x2[3] * x2[3])) + ((x3[0] * x3[0] + x3[1] * x3[1]) + (x3[2] * x3[2] + x3[3] * x3[3]));
                    ss += __shfl_xor(ss, 16); ss += __shfl_xor(ss, 32);
                    if (fq == 0) P[r * 4 + wc] = ss;
                    if (m & 1) asm volatile("" ::: "memory");
                }
        }
        __syncthreads();
        float* slot = xch + (size_t)(u.pm * 4) * 256;
        if (tid < 256) { const f32x4 p = *(const LAS f32x4*)(P + tid * 4); __hip_atomic_store(slot + u.pn * 256 + tid, (p[0] + p[1]) + (p[2] + p[3]), __ATOMIC_RELAXED, __HIP_MEMORY_SCOPE_AGENT);
            asm volatile("s_waitcnt vmcnt(0)" ::: "memory");
            if (lane == 0) __hip_atomic_fetch_add(cnt + 16 * u.pm, 1u, __ATOMIC_RELAXED, __HIP_MEMORY_SCOPE_AGENT); }
        if (wid == 0) {
            unsigned* c = cnt + 16 * u.pm; unsigned spins = 0;
            while ((unsigned)__builtin_amdgcn_readfirstlane(__hip_atomic_load(c, __ATOMIC_RELAXED, __HIP_MEMORY_SCOPE_AGENT)) < 16u) { __builtin_amdgcn_s_sleep(2); if (++spins > (1u << 22)) break; }
            __builtin_amdgcn_fence(__ATOMIC_ACQUIRE, "agent");
        }
        asm volatile("s_waitcnt vmcnt(0) lgkmcnt(0)" ::: "memory");
        __syncthreads();
        if (tid < 256) {
            const float t = (__hip_atomic_load(slot + tid, __ATOMIC_RELAXED, __HIP_MEMORY_SCOPE_AGENT) + __hip_atomic_load(slot + 256 + tid, __ATOMIC_RELAXED, __HIP_MEMORY_SCOPE_AGENT))
                          + (__hip_atomic_load(slot + 512 + tid, __ATOMIC_RELAXED, __HIP_MEMORY_SCOPE_AGENT) + __hip_atomic_load(slot + 768 + tid, __ATOMIC_RELAXED, __HIP_MEMORY_SCOPE_AGENT));
            S[tid] = 1.0f / sqrtf(t * (1.0f / DM) + EPS);
        }
        __syncthreads();
        {
            f32x4 m0, m1, m2, m3, s0, s1, s2, s3;
            if (MODE == 1) { m0 = *(const f32x4*)(fin + colA); m1 = *(const f32x4*)(fin + colA + 4); m2 = *(const f32x4*)(fin + colB); m3 = *(const f32x4*)(fin + colB + 4); }
            else { const float* gq = gs + (size_t)b * DM; const float* sq = sh + (size_t)b * NMOD;
                m0 = *(const f32x4*)(gq + colA); m1 = *(const f32x4*)(gq + colA + 4); m2 = *(const f32x4*)(gq + colB); m3 = *(const f32x4*)(gq + colB + 4);
                s0 = *(const f32x4*)(sq + colA); s1 = *(const f32x4*)(sq + colA + 4); s2 = *(const f32x4*)(sq + colB); s3 = *(const f32x4*)(sq + colB + 4); }
#pragma unroll
            for (int ai = 0; ai < 2; ++ai)
#pragma unroll
                for (int m = 0; m < 4; ++m) {
                    const int r = ai * 128 + wr * 64 + m * 16 + fr; const size_t off = (size_t)(u.pm * 256 + r) * DM; const float rstd = S[r];
                    if (MODE == 1) {
                        *(f32x4*)(xout + off + colA) = acc[ai][0][m][0] * rstd * m0; *(f32x4*)(xout + off + colA + 4) = acc[ai][0][m][1] * rstd * m1;
                        *(f32x4*)(xout + off + colB) = acc[ai][1][m][0] * rstd * m2; *(f32x4*)(xout + off + colB + 4) = acc[ai][1][m][1] * rstd * m3;
                    } else {
                        *(u32x4*)(H + off + colA) = pack8(acc[ai][0][m][0] * rstd * m0 + s0, acc[ai][0][m][1] * rstd * m1 + s1);
                        *(u32x4*)(H + off + colB) = pack8(acc[ai][1][m][0] * rstd * m2 + s2, acc[ai][1][m][1] * rstd * m3 + s3);
                    }
                }
        }
    }
};

__device__ __forceinline__ void transpose_item(const float* W, int ldw, int n0, int k0, bf16_t* WT, int ldk, int row0, int dk0, LAS float* scr, int lane) {
    {
        const int r8 = lane >> 3, c4 = 4 * (lane & 7); f32x4 v[8];
#pragma unroll
        for (int i = 0; i < 8; ++i) v[i] = *(const f32x4*)(W + (size_t)(k0 + 8 * i + r8) * ldw + n0 + c4);
#pragma unroll
        for (int i = 0; i < 8; ++i) { LAS float* d = scr + (8 * i + r8) * 33 + c4; d[0] = v[i][0]; d[1] = v[i][1]; d[2] = v[i][2]; d[3] = v[i][3]; }
    }
    asm volatile("s_waitcnt lgkmcnt(0)" ::: "memory");
    const int c = lane & 7;
#pragma unroll
    for (int j = 0; j < 4; ++j) { const int n = (lane >> 3) + 8 * j; const LAS float* s = scr + (8 * c) * 33 + n;
        u32x4 o; o.x = cvt_pk_bf16(s[0 * 33], s[1 * 33]); o.y = cvt_pk_bf16(s[2 * 33], s[3 * 33]); o.z = cvt_pk_bf16(s[4 * 33], s[5 * 33]); o.w = cvt_pk_bf16(s[6 * 33], s[7 * 33]);
        *(u32x4*)(WT + (size_t)(row0 + n) * ldk + dk0 + 8 * c) = o; }
    asm volatile("s_waitcnt lgkmcnt(0)" ::: "memory");
}

struct Args { const float* in[21]; float* out; unsigned char* ws; };

template <int SET> __device__ __forceinline__ void convert_weights(const Args& a, LAS unsigned char* lds, int gw, int NGW, int lane, int wave);
__device__ __forceinline__ void prologue(const Args& a, LAS unsigned char* lds, int G) {
    LAUNDER_TID();
    unsigned char* ws = a.ws;
    float* mod = (float*)(ws + WS_MOD);
    {
        LAS float* sc = (LAS float*)lds; LAS float* red = (LAS float*)(lds + 16384);
        const float* c = a.in[1]; const float* aw = a.in[2]; const float* ab = a.in[3];
        for (int i = tid; i < 4096; i += 512) { const float v = c[i]; sc[i] = v / (1.0f + expf(-v)); }
        __syncthreads();
        for (int it = blockIdx.x; it < NMOD / 36; it += G) {
            const int j0 = 36 * it, kg = tid / 9, c4 = 4 * (tid - 9 * kg);
            if (kg < 56) {
                f32x4 a0 = {0.f, 0.f, 0.f, 0.f}, a1 = a0, a2 = a0, a3 = a0;
#pragma unroll 4
                for (int k = kg; k < DM; k += 56) { const f32x4 w = *(const f32x4*)(aw + (size_t)k * NMOD + j0 + c4); a0 += sc[k] * w; a1 += sc[1024 + k] * w; a2 += sc[2048 + k] * w; a3 += sc[3072 + k] * w; }
                *(LAS f32x4*)(red + (kg * 4 + 0) * 36 + c4) = a0; *(LAS f32x4*)(red + (kg * 4 + 1) * 36 + c4) = a1; *(LAS f32x4*)(red + (kg * 4 + 2) * 36 + c4) = a2; *(LAS f32x4*)(red + (kg * 4 + 3) * 36 + c4) = a3;
            }
            __syncthreads();
            if (tid < 144) { const int b = tid / 36, j2 = tid - 36 * b; float sm = 0.f;
#pragma unroll 8
                for (int g2 = 0; g2 < 56; ++g2) sm += red[(g2 * 4 + b) * 36 + j2];
                mod[(size_t)b * NMOD + j0 + j2] = sm + ab[j0 + j2]; }
            __syncthreads();
        }
    }
    __syncthreads();
}
template <int SET>
__device__ __forceinline__ void convert_weights(const Args& a, LAS unsigned char* lds, int gw, int NGW, int lane, int wave) {
    unsigned char* ws = a.ws;
    {
        LAS float* scr = (LAS float*)(lds + wave * 16384);
        constexpr int I_GU = 16 * 176, I_D = 44 * 32, I_IN = 16 * 160, I_AB = 8 * 32, I_OUT = 16 * 32;
        constexpr int NSET = SET == 0 ? 2 * I_GU : SET == 1 ? I_D + I_IN + 2 * I_AB + I_OUT : I_D;
        for (int k = gw; k < NSET; k += NGW) {
            int r;
            if (SET == 0) r = k < I_GU ? k : k + I_D;
            else if (SET == 1) r = k < I_D ? I_GU + k : k + (2 * I_GU + I_D);
            else r = 2 * I_GU + I_D + k;
            if (r < 2 * (I_GU + I_D)) {
                const int f = r >= (I_GU + I_D); if (f) r -= (I_GU + I_D);
                if (r < I_GU) { const int kb = r / 176, db = r % 176, tile = db >> 3, wb = db & 7, half = wb >> 2, cc = 32 * (wb & 3);
                    const float* src = a.in[(f ? 17 : 5) + half]; bf16_t* dst = (bf16_t*)(ws + (f ? WS_WGU2 : WS_WGU1));
                    transpose_item(src, DFF, 128 * tile + cc, 64 * kb, dst, DM, 32 * db, 64 * kb, scr, lane); }
                else { r -= I_GU; const int kb = r / 32, db = r % 32; const float* src = a.in[f ? 19 : 7]; bf16_t* dst = (bf16_t*)(ws + (f ? WS_WD2 : WS_WD1));
                    transpose_item(src, DM, 32 * db, 64 * kb, dst, DFF, 32 * db, 64 * kb, scr, lane); }
                continue;
            }
            r -= 2 * (I_GU + I_D);
            if (r < I_IN) { const int kb = r / 160, db = r % 160, d0 = 32 * db; int sc0;
                if (d0 < 1536) sc0 = d0; else if (d0 < 3072) sc0 = d0 + 8; else { const int e = d0 - 3072; sc0 = 3080 + ((e >> 7) & 1) * 1024 + 128 * (e >> 8) + (e & 127); }
                transpose_item(a.in[9], INC, sc0, 64 * kb, (bf16_t*)(ws + WS_WIN), DM, d0, 64 * kb, scr, lane); continue; }
            r -= I_IN;
            if (r < 2 * I_AB) { const int part = r >= I_AB; if (part) r -= I_AB; const int kb = r / 32, db = r % 32;
                transpose_item(a.in[13 + part], DM, 32 * db, 64 * kb, (bf16_t*)(ws + WS_WAB), DM, 32 * db, 512 * part + 64 * kb, scr, lane); continue; }
            r -= 2 * I_AB;
            { const int kb = r / 32, db = r % 32; transpose_item(a.in[15], DM, 32 * db, 64 * kb, (bf16_t*)(ws + WS_WOUT), DM, 32 * db, 64 * kb, scr, lane); }
        }
    }
}

template <bool FORGET>
__device__ __forceinline__ void norm_phase(const float* xin, const float* gamma, const float* shift, const float* scale, bf16_t* out,
                                           const float* w_in, const float* forget_b, float* logf, LAS unsigned char* lds, int G) {
    LAUNDER_TID();
    LAS float* wf = (LAS float*)lds;
    if (FORGET) { for (int i = tid; i < 8192; i += 512) wf[i] = w_in[(size_t)(i >> 3) * INC + 1536 + (i & 7)]; __syncthreads(); }
    const int gw = blockIdx.x * 8 + wave, NGW = G * 8;
    for (int row = gw; row < T_TOK; row += NGW) {
        const int b = row >> 12; const float* xr = xin + (size_t)row * DM + 4 * lane;
        f32x4 v[4]; float ss = 0.f;
#pragma unroll
        for (int j = 0; j < 4; ++j) { v[j] = *(const f32x4*)(xr + 256 * j); ss += (v[j][0] * v[j][0] + v[j][1] * v[j][1]) + (v[j][2] * v[j][2] + v[j][3] * v[j][3]); }
        const float rstd = 1.0f / sqrtf(wave_sum(ss) * (1.0f / DM) + EPS);
        float fa[8];
        if (FORGET) {
#pragma unroll
            for (int q = 0; q < 8; ++q) fa[q] = 0.f;
        }
#pragma unroll
        for (int j = 0; j < 4; ++j) {
            const int col = 256 * j + 4 * lane;
            const f32x4 gm = *(const f32x4*)(gamma + col), sc = *(const f32x4*)(scale + (size_t)b * NMOD + col), sh = *(const f32x4*)(shift + (size_t)b * NMOD + col);
            const f32x4 hv = v[j] * rstd * gm * (1.0f + sc) + sh;
            u32x2 w; w.x = cvt_pk_bf16(hv[0], hv[1]); w.y = cvt_pk_bf16(hv[2], hv[3]);
            *(u32x2*)(out + (size_t)row * DM + col) = w;
            if (FORGET) {
#pragma unroll
                for (int e = 0; e < 4; ++e) { const f32x4 w0 = *(const LAS f32x4*)(wf + (col + e) * 8), w1 = *(const LAS f32x4*)(wf + (col + e) * 8 + 4);
#pragma unroll
                    for (int q = 0; q < 4; ++q) { fa[q] += hv[e] * w0[q]; fa[4 + q] += hv[e] * w1[q]; } }
            }
        }
        if (FORGET) {
            float mine = 0.f;
#pragma unroll
            for (int q = 0; q < 8; ++q) { const float s = wave_sum(fa[q]); if (lane == q) mine = s; }
            if (lane < 8) { const float z = mine + forget_b[lane];
                const float ls = z > 0.f ? -log1pf(expf(-z)) : z - log1pf(expf(z));
                logf[(size_t)row * 8 + lane] = ls; }
        }
    }
    if (FORGET) __syncthreads();
}

__device__ __forceinline__ void scan_phase(const float* logf, float* F2, LAS unsigned char* lds, int G) {
    LAUNDER_TID();
    LAS float* wt = (LAS float*)lds;
    for (int seq = blockIdx.x; seq < 32; seq += G) {
        const int b = seq >> 3, h = seq & 7, s0 = 8 * tid;
        float run[8]; float acc = 0.f;
#pragma unroll
        for (int e = 0; e < 8; ++e) { acc += logf[((size_t)b * SEQ + s0 + e) * 8 + h]; run[e] = acc; }
        float inc = acc;
#pragma unroll
        for (int o = 1; o < 64; o <<= 1) { const float t = __shfl_up(inc, o); if (lane >= o) inc += t; }
        if (lane == 63) wt[wave] = inc;
        __syncthreads();
        float off = inc - acc;
        for (int w2 = 0; w2 < wave; ++w2) off += wt[w2];
#pragma unroll
        for (int e = 0; e < 8; ++e) F2[(size_t)seq * SEQ + s0 + e] = (off + run[e]) * LOG2E;
        __syncthreads();
    }
}

__device__ __forceinline__ void fa_phase(const bf16_t* Hh, const float* wfg, const float* forget_b, float* logfT, LAS unsigned char* lds, int G) {
    LAUNDER_TID();
    LAS float* wf = (LAS float*)lds;
    for (int i = tid; i < 2048; i += 512) *(LAS f32x4*)(wf + 4 * i) = *(const f32x4*)(wfg + 4 * i);
    __syncthreads();
    const int gw = blockIdx.x * 8 + wave, NGW = G * 8;
    for (int row = gw; row < T_TOK; row += 2 * NGW) {
        const int row2 = row + NGW; const bool has2 = row2 < T_TOK; const int rb = has2 ? row2 : row;
        u32x4 ha[2], hb[2];
#pragma unroll
        for (int hh = 0; hh < 2; ++hh) { ha[hh] = *(const u32x4*)(Hh + (size_t)row * DM + 512 * hh + 8 * lane); hb[hh] = *(const u32x4*)(Hh + (size_t)rb * DM + 512 * hh + 8 * lane); }
        float fa[8], fb[8];
#pragma unroll
        for (int q = 0; q < 8; ++q) { fa[q] = 0.f; fb[q] = 0.f; }
#pragma unroll
        for (int hh = 0; hh < 2; ++hh) {
            const int col = 512 * hh + 8 * lane;
#pragma unroll
            for (int e = 0; e < 8; ++e) {
                const unsigned wa = ha[hh][e >> 1], wb = hb[hh][e >> 1];
                const float va = __uint_as_float((e & 1) ? (wa & 0xffff0000u) : (wa << 16)), vb = __uint_as_float((e & 1) ? (wb & 0xffff0000u) : (wb << 16));
                const f32x4 w0 = *(const LAS f32x4*)(wf + (col + e) * 8), w1 = *(const LAS f32x4*)(wf + (col + e) * 8 + 4);
#pragma unroll
                for (int q = 0; q < 4; ++q) { fa[q] += va * w0[q]; fa[4 + q] += va * w1[q]; fb[q] += vb * w0[q]; fb[4 + q] += vb * w1[q]; } }
        }
        float ma = 0.f, mb = 0.f;
#pragma unroll
        for (int q = 0; q < 8; ++q) { const float sa = wave_sum(fa[q]), sb = wave_sum(fb[q]); if (lane == q) { ma = sa; mb = sb; } }
        if (lane < 8) { const float fbias = forget_b[lane];
            { const float z = ma + fbias; logfT[((size_t)(row >> 12) * 8 + lane) * SEQ + (row & 4095)] = z > 0.f ? -log1pf(expf(-z)) : z - log1pf(expf(z)); }
            if (has2) { const float z = mb + fbias; logfT[((size_t)(row2 >> 12) * 8 + lane) * SEQ + (row2 & 4095)] = z > 0.f ? -log1pf(expf(-z)) : z - log1pf(expf(z)); } }
    }
    __syncthreads();
}
__device__ __forceinline__ void scan_block(const float* logf, int b, int h, LAS float* FL, LAS float* wt) {
    LAUNDER_TID();
    const int s0 = 8 * tid;
    float run[8]; float acc = 0.f;
    const float* lp = logf + ((size_t)b * 8 + h) * SEQ + s0; const f32x4 l0 = *(const f32x4*)lp, l1 = *(const f32x4*)(lp + 4);
#pragma unroll
    for (int e = 0; e < 8; ++e) { acc += (e < 4 ? l0[e & 3] : l1[e & 3]); run[e] = acc; }
    float inc = acc;
#pragma unroll
    for (int o = 1; o < 64; o <<= 1) { const float t = __shfl_up(inc, o); if (lane >= o) inc += t; }
    if (lane == 63) wt[wave] = inc;
    __syncthreads();
    float off = inc - acc;
    for (int w2 = 0; w2 < wave; ++w2) off += wt[w2];
#pragma unroll
    for (int e = 0; e < 8; ++e) FL[s0 + e] = (off + run[e]) * LOG2E;
    __syncthreads();
}

constexpr int AT_ROWB = 144, AT_K = 0, AT_V = 64 * AT_ROWB, AT_F = 2 * 64 * AT_ROWB, AT_SLOT = AT_F + 256, AT_TBL = 2 * AT_SLOT, AT_FL = 40960, AT_WT = AT_FL + 16384;
__device__ __forceinline__ float max3f(float a, float b, float c) { return __builtin_fmaxf(__builtin_fmaxf(a, b), c); }
__device__ __forceinline__ u32x4 f3split(float f) {
    const unsigned h = cvt_pk_bf16(f, 0.f) & 0xffffu; const float r1 = f - __uint_as_float(h << 16);
    const unsigned m = cvt_pk_bf16(r1, 0.f) & 0xffffu; const float r2 = r1 - __uint_as_float(m << 16);
    const unsigned l = cvt_pk_bf16(r2, 0.f) & 0xffffu;
    u32x4 w; w.x = h | (m << 16); w.y = l; w.z = 0u; w.w = 0u; return w; }
constexpr float AT_THR = 6.0f;
template <int MODE>
__device__ __forceinline__ void attn_unit(LAS unsigned char* lds, const bf16_t* Q, const bf16_t* K, const bf16_t* Vt, const LAS float* fg, const float* relb,
                                          bf16_t* O, int ocol, int b, int h, int qb) {
    LAUNDER_TID(); const int w = wave;
    const int q32 = lane & 31, hi = lane >> 5;
    const int q0 = qb * 256, qloc = q0 + 32 * w + q32;
    const size_t tokbase = (size_t)b * SEQ;
    bf16x8 qf[4];
    { const bf16_t* qp = Q + (tokbase + qloc) * 512 + h * 64 + hi * 8;
#pragma unroll
      for (int d0 = 0; d0 < 4; ++d0) qf[d0] = *(const bf16x8*)(qp + 16 * d0); }
    int t_lo, t_hi, wt_lo, wt_hi; const int cw = 4 * qb + (w >> 1);
    if (MODE == 0) { t_lo = 0; t_hi = 4 * qb + 3; wt_lo = 0; wt_hi = cw; }
    else { t_lo = 4 * qb - 8 > 0 ? 4 * qb - 8 : 0; t_hi = 4 * qb + 3; wt_lo = cw - 8 > 0 ? cw - 8 : 0; wt_hi = cw; }
    const int nt = t_hi - t_lo + 1, dir = (MODE == 0) ? -1 : 1, t0 = (MODE == 0) ? t_hi : t_lo;
    const int sr = tid >> 3, sch = tid & 7;
    const bf16_t* kg = K + (tokbase + sr) * 512 + h * 64 + sch * 8;
    const bf16_t* vg = Vt + ((size_t)(b * 8 + h) * 64 + sr) * SEQ + sch * 8;
    float fref = 0.f; if (MODE == 0) fref = fg[q0];
    const int sdst = sr * AT_ROWB + sch * 16;
    u32x4 kreg, vreg; float freg = 0.f;
    kreg = *(const u32x4*)(kg + (size_t)t0 * 64 * 512); vreg = *(const u32x4*)(vg + t0 * 64);
    if (MODE == 0 && tid < 64) freg = fref - fg[t0 * 64 + tid];
    *(LAS u32x4*)(lds + AT_K + sdst) = kreg; *(LAS u32x4*)(lds + AT_V + sdst) = vreg;
    if (MODE == 0 && tid < 64) *(LAS u32x4*)(lds + AT_K + tid * AT_ROWB + 128) = f3split(freg);
    if (MODE == 1) { for (int i = tid; i < 257; i += 512) *(LAS float*)(lds + AT_TBL + 4 * i) = relb[i] * LOG2E; }
    __syncthreads();
    float m = 0.f, l = 0.f; f32x16 o0, o1, negm; int first = 1;
#pragma unroll
    for (int r = 0; r < 16; ++r) { o0[r] = 0.f; o1[r] = 0.f; negm[r] = 0.f; }
    asm volatile("" : "+v"(negm));
    const int krow = (q32 & 0x13) | ((q32 & 4) << 1) | ((q32 & 8) >> 1);
    const short one_b = hi ? (short)0 : (short)0x3F80;
    const bf16x8 qx = (bf16x8){one_b, one_b, one_b, 0, 0, 0, 0, 0};
    for (int j = 0; j < nt; ++j) {
        const int t = t0 + dir * j, cur = j & 1;
        if (j + 1 < nt) { const int tn = t + dir; kreg = *(const u32x4*)(kg + (size_t)tn * 64 * 512); vreg = *(const u32x4*)(vg + tn * 64);
            if (MODE == 0 && tid < 64) freg = fref - fg[tn * 64 + tid]; }
        if (t >= wt_lo && t <= wt_hi) {
            const LAS unsigned char* Ks = lds + cur * AT_SLOT + AT_K; const LAS unsigned char* Vs = lds + cur * AT_SLOT + AT_V; const LAS float* Fs = (const LAS float*)(lds + cur * AT_SLOT + AT_F);
            f32x16 p0, p1;
            const LAS unsigned char* ka = Ks + krow * AT_ROWB + hi * 16;
            {   const bf16x8 a0 = *(const LAS bf16x8*)(ka), a1 = *(const LAS bf16x8*)(ka + 32 * AT_ROWB);
                p0 = __builtin_amdgcn_mfma_f32_32x32x16_bf16(a0, qf[0], negm, 0, 0, 0);
                p1 = __builtin_amdgcn_mfma_f32_32x32x16_bf16(a1, qf[0], negm, 0, 0, 0); }
#pragma unroll
            for (int d0 = 1; d0 < 4; ++d0) {
                const bf16x8 a0 = *(const LAS bf16x8*)(ka + 32 * d0), a1 = *(const LAS bf16x8*)(ka + 32 * AT_ROWB + 32 * d0);
                p0 = __builtin_amdgcn_mfma_f32_32x32x16_bf16(a0, qf[d0], p0, 0, 0, 0);
                p1 = __builtin_amdgcn_mfma_f32_32x32x16_bf16(a1, qf[d0], p1, 0, 0, 0);
            }
            if (MODE == 0) {
                {   const bf16x8 ax0 = *(const LAS bf16x8*)(ka + 128), ax1 = *(const LAS bf16x8*)(ka + 32 * AT_ROWB + 128);
                    p0 = __builtin_amdgcn_mfma_f32_32x32x16_bf16(ax0, qx, p0, 0, 0, 0);
                    p1 = __builtin_amdgcn_mfma_f32_32x32x16_bf16(ax1, qx, p1, 0, 0, 0); }
                if (64 * t + 63 > q0 + 32 * w) {
                    const int lim = qloc - 64 * t - 8 * hi;
#pragma unroll
                    for (int r = 0; r < 16; ++r) { const int kc = 16 * (r >> 3) + (r & 7); if (kc > lim) p0[r] = -1e30f; if (kc + 32 > lim) p1[r] = -1e30f; }
                }
            } else {
                const LAS float* tbl = (const LAS float*)(lds + AT_TBL);
                if (cw - t >= 3) { const float bc = tbl[256];
#pragma unroll
                    for (int r = 0; r < 16; ++r) { p0[r] += bc; p1[r] += bc; } }
                else { const int base = qloc - 64 * t - 8 * hi + 128;
#pragma unroll
                    for (int r = 0; r < 16; ++r) { const int kc = 16 * (r >> 3) + (r & 7);
                        int i0 = base - kc; i0 = i0 < 0 ? 0 : (i0 > 256 ? 256 : i0); int i1 = base - kc - 32; i1 = i1 < 0 ? 0 : (i1 > 256 ? 256 : i1);
                        p0[r] += tbl[i0]; p1[r] += tbl[i1]; } }
            }
            float ma = p0[0], mb = p1[0];
#pragma unroll
            for (int r = 1; r < 15; r += 2) { ma = max3f(ma, p0[r], p0[r + 1]); mb = max3f(mb, p1[r], p1[r + 1]); }
            float mt = __builtin_fmaxf(max3f(ma, mb, p0[15]), p1[15]);
            mt = __builtin_fmaxf(mt, __shfl_xor(mt, 32));
            if (first || __builtin_amdgcn_ballot_w64(mt > AT_THR) != 0ull) {
                const float d = first ? mt : __builtin_fmaxf(mt, 0.f);
                m += d;
#pragma unroll
                for (int r = 0; r < 16; ++r) { p0[r] -= d; p1[r] -= d; }
                if (!first) { const float alpha = __builtin_amdgcn_exp2f(-d); l *= alpha;
#pragma unroll
                    for (int r = 0; r < 16; ++r) { o0[r] *= alpha; o1[r] *= alpha; } }
#pragma unroll
                for (int r = 0; r < 16; ++r) negm[r] = -m;
                asm volatile("" : "+v"(negm));
                first = 0;
            }
            float ls0 = 0.f, ls1 = 0.f;
#pragma unroll
            for (int r = 0; r < 16; ++r) { p0[r] = __builtin_amdgcn_exp2f(p0[r]); p1[r] = __builtin_amdgcn_exp2f(p1[r]); ls0 += p0[r]; ls1 += p1[r]; }
            l += ls0 + ls1;
            const LAS unsigned char* va = Vs + q32 * AT_ROWB + hi * 16;
#pragma unroll
            for (int ph = 0; ph < 2; ++ph)
#pragma unroll
                for (int jj = 0; jj < 2; ++jj) {
                    u32x4 pw;
                    if (ph == 0) { pw.x = cvt_pk_bf16(p0[8 * jj + 0], p0[8 * jj + 1]); pw.y = cvt_pk_bf16(p0[8 * jj + 2], p0[8 * jj + 3]); pw.z = cvt_pk_bf16(p0[8 * jj + 4], p0[8 * jj + 5]); pw.w = cvt_pk_bf16(p0[8 * jj + 6], p0[8 * jj + 7]); }
                    else { pw.x = cvt_pk_bf16(p1[8 * jj + 0], p1[8 * jj + 1]); pw.y = cvt_pk_bf16(p1[8 * jj + 2], p1[8 * jj + 3]); pw.z = cvt_pk_bf16(p1[8 * jj + 4], p1[8 * jj + 5]); pw.w = cvt_pk_bf16(p1[8 * jj + 6], p1[8 * jj + 7]); }
                    const bf16x8 pb = __builtin_bit_cast(bf16x8, pw);
                    const bf16x8 v0 = *(const LAS bf16x8*)(va + 64 * ph + 32 * jj), v1 = *(const LAS bf16x8*)(va + 32 * AT_ROWB + 64 * ph + 32 * jj);
                    o0 = __builtin_amdgcn_mfma_f32_32x32x16_bf16(v0, pb, o0, 0, 0, 0);
                    o1 = __builtin_amdgcn_mfma_f32_32x32x16_bf16(v1, pb, o1, 0, 0, 0);
                }
        }
        if (j + 1 < nt) { const int nb = (cur ^ 1) * AT_SLOT;
            *(LAS u32x4*)(lds + nb + AT_K + sdst) = kreg; *(LAS u32x4*)(lds + nb + AT_V + sdst) = vreg;
            if (MODE == 0 && tid < 64) *(LAS u32x4*)(lds + nb + AT_K + tid * AT_ROWB + 128) = f3split(freg); }
        __syncthreads();
    }
    l += __shfl_xor(l, 32);
    const float inv = 1.0f / l;
    bf16_t* op = O + (tokbase + qloc) * DM + ocol + 4 * hi;
#pragma unroll
    for (int g = 0; g < 4; ++g) {
        u32x2 w0, w1;
        w0.x = cvt_pk_bf16(o0[4 * g] * inv, o0[4 * g + 1] * inv); w0.y = cvt_pk_bf16(o0[4 * g + 2] * inv, o0[4 * g + 3] * inv);
        w1.x = cvt_pk_bf16(o1[4 * g] * inv, o1[4 * g + 1] * inv); w1.y = cvt_pk_bf16(o1[4 * g + 2] * inv, o1[4 * g + 3] * inv);
        *(u32x2*)(op + 8 * g) = w0; *(u32x2*)(op + 32 + 8 * g) = w1;
    }
}

#define XB_TMO      128
#define XB_XCNT(j)  (256  + 64 * (j))
#define XB_XSUB(j)  (1280 + 64 * (j))
#define XB_XGEN(j)  (2304 + 64 * (j))
#define XB_TOP      3328
#define XB_TOPGEN   3392
#define XCD_BAR_WORDS 3456
#define XB_SPIN_CAP (1u << 18)

__device__ __forceinline__ unsigned xb_ld(unsigned* p)              { return __hip_atomic_load(p, __ATOMIC_RELAXED, __HIP_MEMORY_SCOPE_AGENT); }
__device__ __forceinline__ unsigned xb_add(unsigned* p, unsigned v) { return __hip_atomic_fetch_add(p, v, __ATOMIC_RELAXED, __HIP_MEMORY_SCOPE_AGENT); }
__device__ __forceinline__ unsigned xb_xcc_id() { return (unsigned)__builtin_amdgcn_s_getreg((3 << 11) | 20) & 0xFu; }
#define XB_SPIN(cond, bar) do { unsigned _sp = 0; while (cond) { __builtin_amdgcn_s_sleep(1); \
    if ((++_sp & 255u) == 0u) { if (xb_ld(&(bar)[XB_TMO])) break; if (_sp > XB_SPIN_CAP) { atomicAdd(&(bar)[XB_TMO], 1u); break; } } } } while (0)

struct XcdBarrier {
    unsigned* bar; unsigned x;
    volatile LAS unsigned* st;
};

__device__ __forceinline__ XcdBarrier xcd_barrier_post(unsigned* bar, volatile LAS unsigned* st) {
    XcdBarrier b; b.bar = bar; b.x = xb_xcc_id(); b.st = st;
    if (threadIdx.x == 0) (void)xb_add(&bar[XB_XCNT(b.x)], 1u);
    return b;
}
__device__ __forceinline__ void xcd_barrier_complete(unsigned* bar, unsigned x, unsigned& nloc, unsigned& nx) {
    const unsigned G = gridDim.x * gridDim.y * gridDim.z;
    unsigned sum, cnt, mine, sp = 0u;
    for (;;) {
        sum = 0u; cnt = 0u; mine = 0u;
#pragma unroll
        for (unsigned j = 0; j < 16; ++j) { const unsigned c = xb_ld(&bar[XB_XCNT(j)]); sum += c; cnt += (c > 0u) ? 1u : 0u; mine = (j == x) ? c : mine; }
        if (sum == G) break;
        __builtin_amdgcn_s_sleep(1);
        if ((++sp & 255u) == 0u) { if (xb_ld(&bar[XB_TMO])) break; if (sp > XB_SPIN_CAP) { atomicAdd(&bar[XB_TMO], 1u); break; } }
    }
    nloc = mine > 0u ? mine : 1u; nx = cnt > 0u ? cnt : 1u;
}

__device__ __forceinline__ void xcd_barrier(const XcdBarrier& b) {
    asm volatile("s_waitcnt vmcnt(0)" ::: "memory");
    __syncthreads();
    if (threadIdx.x == 0) {
        unsigned* bar = b.bar;
        __builtin_amdgcn_s_waitcnt(0);
        unsigned nloc = b.st[0], nx = b.st[1];
        if (nloc == 0u) { xcd_barrier_complete(bar, b.x, nloc, nx); b.st[0] = nloc; b.st[1] = nx; }
        const unsigned old = xb_add(&bar[XB_XSUB(b.x)], 1u);
        const unsigned gen = old / nloc;
        if (old + 1u == (gen + 1u) * nloc) {
            __builtin_amdgcn_fence(__ATOMIC_RELEASE, "agent");
            asm volatile("s_waitcnt vmcnt(0)" ::: "memory");
            const unsigned og = xb_add(&bar[XB_TOP], 1u);
            const unsigned tg = og / nx;
            if (og + 1u == (tg + 1u) * nx) xb_add(&bar[XB_TOPGEN], 1u);
            else XB_SPIN(xb_ld(&bar[XB_TOPGEN]) == tg, bar);
            __builtin_amdgcn_fence(__ATOMIC_ACQUIRE, "agent");
            xb_add(&bar[XB_XGEN(b.x)], 1u);
            asm volatile("s_waitcnt vmcnt(0)" ::: "memory");
        } else {
            XB_SPIN(xb_ld(&bar[XB_XGEN(b.x)]) == gen, bar);
            __builtin_amdgcn_fence(__ATOMIC_ACQUIRE, "agent");
            asm volatile("s_waitcnt vmcnt(0)" ::: "memory");
        }
    }
    __syncthreads();
}

__global__ void __launch_bounds__(512, 2) mega_fwd(Args a) {
    extern __shared__ __attribute__((aligned(16))) unsigned char lds_raw[];
    LAS unsigned char* lds = (LAS unsigned char*)lds_raw;
    cg::grid_group grid = cg::this_grid();
    if (threadIdx.x < 64) ((LAS unsigned*)(lds + 131072))[threadIdx.x] = 0u;
    if (blockIdx.x == 0) { for (int i = threadIdx.x; i < (int)(BAR_BYTES / 4); i += 512) ((unsigned*)(a.ws + WS_BAR))[i] = 0u; asm volatile("s_waitcnt vmcnt(0)" ::: "memory"); }
    __syncthreads();
    const int G = gridDim.x;
    const int vcu = (G % 8 == 0) ? ((int)blockIdx.x % 8) * (G / 8) + (int)blockIdx.x / 8 : (int)blockIdx.x;
    unsigned char* ws = a.ws;
    float* mod = (float*)(ws + WS_MOD); float* logf = (float*)(ws + WS_LOGF); float* F2 = (float*)(ws + WS_F2);
    bf16_t* H = (bf16_t*)(ws + WS_H); bf16_t* ACT = (bf16_t*)(ws + WS_ACT);
    const float* x = a.in[0]; float* out = a.out;
    constexpr bool AL = true, SP = true;

    grid.sync();
    const XcdBarrier xbar = xcd_barrier_post((unsigned*)(a.ws + WS_BAR), (volatile LAS unsigned*)(lds + 131072));
    for (int r_ = 0; r_ < R_P0; ++r_) prologue(a, lds, G);
    xcd_barrier(xbar);
    { const int gid = blockIdx.x * 512 + threadIdx.x;
      if (gid < 8192) { const int which = gid >> 12, bb = (gid >> 10) & 3, col = gid & 1023;
          ((float*)(ws + (which ? WS_GS3 : WS_GS2)))[bb * DM + col] = a.in[which ? 16 : 8][col] * (1.0f + mod[(size_t)bb * NMOD + (which ? 7 : 4) * DM + col]); }
      else if (gid < 16384) { const int i = gid - 8192; ((float*)(ws + WS_WF))[i] = a.in[9][(size_t)(i >> 3) * INC + 1536 + (i & 7)]; } }
    for (int r_ = 0; r_ < R_P1; ++r_) norm_phase<false>(x, a.in[4], mod + 0 * DM, mod + 1 * DM, H, nullptr, nullptr, nullptr, lds, G);
    { LAUNDER_TID(); convert_weights<0>(a, lds, (int)blockIdx.x * 8 + wave, G * 8, lane, wave); }
    xcd_barrier(xbar);
    if (PHMASK & 4) { pg8::Gemm g{H, (const bf16_t*)(ws + WS_WGU1), T_TOK, 2 * DFF, DM}; pg8::StaticOrderT<R_P2> S; S.init(T_TOK, 2 * DFF, G, (int)blockIdx.x);
      Epi<QSwiglu> E{{ACT}}; pg8::gemm_phase<Epi<QSwiglu>, pg8::StaticOrderT<R_P2>, AL, SP>(lds, g, S, E); }
    if (G == 256 && blockIdx.x >= 128) { LAUNDER_TID(); convert_weights<1>(a, lds, ((int)blockIdx.x - 128) * 8 + wave, 1024, lane, wave); }
    else if (G != 256) { LAUNDER_TID(); convert_weights<1>(a, lds, (int)blockIdx.x * 8 + wave, G * 8, lane, wave); }
    xcd_barrier(xbar);
    { pg8::Gemm g{ACT, (const bf16_t*)(ws + WS_WD1), T_TOK, DM, DFF}; pg8::StaticOrder S; S.init(T_TOK, DM, G, (int)blockIdx.x);
      EpiResNorm<0> E{x, out, mod + 2 * DM, 0.5f, H, (const float*)(ws + WS_GS2), mod + 3 * DM, nullptr, (float*)(ws + WS_XCH), (unsigned*)(ws + WS_CNT)};
      pg8::gemm_phase<EpiResNorm<0>, pg8::StaticOrder, false, SP>(lds, g, S, E); }
    xcd_barrier(xbar);
    fa_phase(H, (const float*)(ws + WS_WF), a.in[10], logf, lds, G);
    if (PHMASK & 64) { pg8::Gemm g{H, (const bf16_t*)(ws + WS_WIN), T_TOK, 5120, DM}; pg8::StaticOrderT<R_P5> S; S.init(T_TOK, 5120, G, (int)blockIdx.x);
      Epi<QWin> E{{(bf16_t*)(ws + WS_QA), (bf16_t*)(ws + WS_KA), (bf16_t*)(ws + WS_VTA), (bf16_t*)(ws + WS_QB), (bf16_t*)(ws + WS_KB), (bf16_t*)(ws + WS_VTB),
                   (_Float16*)(ws + WS_RATIO), (_Float16*)(ws + WS_GB), a.in[11]}};
      pg8::gemm_phase<Epi<QWin>, pg8::StaticOrderT<R_P5>, AL, SP>(lds, g, S, E); }
    xcd_barrier(xbar);
    if (PHMASK & 128) { bf16_t* ATT = (bf16_t*)(ws + WS_ATT);
      for (int i = vcu; i < 256 * ATT_REPS; i += G) {
          const int bh = (i & 255) >> 3, s = i & 7, b = bh >> 3, h = bh & 7;
          const LAS float* FL = (const LAS float*)(lds + AT_FL);
          scan_block(logf, b, h, (LAS float*)(lds + AT_FL), (LAS float*)(lds + AT_WT));
          attn_unit<0>(lds, (const bf16_t*)(ws + WS_QA), (const bf16_t*)(ws + WS_KA), (const bf16_t*)(ws + WS_VTA), FL, nullptr, ATT, h * 64, b, h, s);
          attn_unit<0>(lds, (const bf16_t*)(ws + WS_QA), (const bf16_t*)(ws + WS_KA), (const bf16_t*)(ws + WS_VTA), FL, nullptr, ATT, h * 64, b, h, 15 - s);
          attn_unit<1>(lds, (const bf16_t*)(ws + WS_QB), (const bf16_t*)(ws + WS_KB), (const bf16_t*)(ws + WS_VTB), FL, a.in[12] + h * 257, ATT, 512 + h * 64, b, h, 2 * s);
          attn_unit<1>(lds, (const bf16_t*)(ws + WS_QB), (const bf16_t*)(ws + WS_KB), (const bf16_t*)(ws + WS_VTB), FL, a.in[12] + h * 257, ATT, 512 + h * 64, b, h, 2 * s + 1);
      } }
    xcd_barrier(xbar);
    { pg8::Gemm g{(const bf16_t*)(ws + WS_ATT), (const bf16_t*)(ws + WS_WAB), T_TOK, DM, DM}; pg8::StaticOrderT<R_P7> S; S.init(T_TOK, DM, G, (int)blockIdx.x);
      Epi<QGate> E{{(const _Float16*)(ws + WS_RATIO), (const _Float16*)(ws + WS_GB), (bf16_t*)(ws + WS_M)}};
      pg8::gemm_phase<Epi<QGate>, pg8::StaticOrderT<R_P7>, AL, SP, 8>(lds, g, S, E); }
    xcd_barrier(xbar);
    { pg8::Gemm g{(const bf16_t*)(ws + WS_M), (const bf16_t*)(ws + WS_WOUT), T_TOK, DM, DM}; pg8::StaticOrder S; S.init(T_TOK, DM, G, (int)blockIdx.x);
      EpiResNorm<0> E{out, out, mod + 5 * DM, 1.0f, H, (const float*)(ws + WS_GS3), mod + 6 * DM, nullptr, (float*)(ws + WS_XCH) + 65536, (unsigned*)(ws + WS_CNT) + 1024};
      pg8::gemm_phase<EpiResNorm<0>, pg8::StaticOrder, false, SP>(lds, g, S, E); }
    xcd_barrier(xbar);
    if (PHMASK & 2048) { pg8::Gemm g{H, (const bf16_t*)(ws + WS_WGU2), T_TOK, 2 * DFF, DM}; pg8::StaticOrder S; S.init(T_TOK, 2 * DFF, G, (int)blockIdx.x);
      Epi<QSwiglu> E{{ACT}}; pg8::gemm_phase<Epi<QSwiglu>, pg8::StaticOrder, AL, SP>(lds, g, S, E); }
    if (G == 256 && blockIdx.x >= 128) { LAUNDER_TID(); convert_weights<2>(a, lds, ((int)blockIdx.x - 128) * 8 + wave, 1024, lane, wave); }
    else if (G != 256) { LAUNDER_TID(); convert_weights<2>(a, lds, (int)blockIdx.x * 8 + wave, G * 8, lane, wave); }
    xcd_barrier(xbar);
    {
      pg8::Gemm g{ACT, (const bf16_t*)(ws + WS_WD2), T_TOK, DM, DFF}; pg8::StaticOrder S; S.init(T_TOK, DM, G, (int)blockIdx.x);
      EpiResNorm<1> E{out, out, mod + 8 * DM, 0.5f, nullptr, nullptr, nullptr, a.in[20], (float*)(ws + WS_XCH) + 2 * 65536, (unsigned*)(ws + WS_CNT) + 2 * 1024};
      pg8::gemm_phase<EpiResNorm<1>, pg8::StaticOrder, false, SP>(lds, g, S, E); }
}

extern "C" void kernel_launch(void* const* d_in, const int* in_sizes, int n_in, void* d_out, int out_size, void* d_ws, size_t ws_size, hipStream_t stream) {
    static int grid = 0;
    if (grid == 0) {
        if (n_in != 21 || out_size != T_TOK * DM || ws_size < WS_END) { fprintf(stderr, "kernel_launch: unexpected shapes (n_in %d out %d ws %zu)\n", n_in, out_size, ws_size); grid = -1; return; }
        int dev = 0, cus = 0, per_cu = 0;
        hipGetDevice(&dev); hipDeviceGetAttribute(&cus, hipDeviceAttributeMultiprocessorCount, dev);
        hipFuncSetAttribute((const void*)mega_fwd, hipFuncAttributeMaxDynamicSharedMemorySize, LDS_BYTES);
        hipOccupancyMaxActiveBlocksPerMultiprocessor(&per_cu, (const void*)mega_fwd, 512, LDS_BYTES);
        if (per_cu < 1) per_cu = 1;
        (void)hipGetLastError();
        grid = cus * per_cu;
    }
    if (grid < 0) return;
    Args a{};
    for (int i = 0; i < 21; ++i) a.in[i] = (const float*)d_in[i];
    a.out = (float*)d_out; a.ws = (unsigned char*)d_ws;
    void* args[] = {&a};
    hipError_t e = hipLaunchCooperativeKernel((const void*)mega_fwd, dim3(grid), dim3(512), args, LDS_BYTES, stream);
    if (e != hipSuccess) fprintf(stderr, "cooperative launch failed: %s (grid %d)\n", hipGetErrorString(e), grid);
}
```
